# Optimizing an MI355X kernel written in HIP

```python
import jax, jax.numpy as jnp
from jax import lax
import numpy as np

D_MODEL = 2048
BATCH = 8
SEQ = 4096
DEPTH = 2

CHUNK = 64
N_PREV = 8
N_BAND = N_PREV + 1
MEM_LEN = 256
HEAD_DIM = 128
W_A = 512
CONV_WIDTH = 3
H_B = 8
W_B = H_B * HEAD_DIM
H_M = 4
W_M = H_M * HEAD_DIM
N_BRANCH = 3
MAX_REL = 256
EPS = 1e-6
SPLIT_SIZES = (W_A, W_A, W_A, W_A,
               W_B, W_B, W_B, W_B,
               W_M, W_M,
               D_MODEL, D_MODEL, D_MODEL)
N_IN = sum(SPLIT_SIZES)

kernel_name = "hybrid_gated_conv_chunkattn_memory"


def rms_norm(x, g):
    xf = x.astype(jnp.float32)
    y = xf * lax.rsqrt(jnp.mean(xf * xf, axis=-1, keepdims=True) + EPS)
    return (y * g.astype(jnp.float32)).astype(x.dtype)


def short_conv_mixer(b, c, xin, conv_w):
    u = c * xin
    s = u.shape[1]
    up = jnp.pad(u, ((0, 0), (CONV_WIDTH - 1, 0), (0, 0)))
    y = up[:, 0:s] * conv_w[0]
    for tap in range(1, CONV_WIDTH):
        y = y + up[:, tap:tap + s] * conv_w[tap]
    return b * y


def relative_bias(rel_table):
    j = jnp.arange(N_BAND, dtype=jnp.int32)[:, None, None]
    iq = jnp.arange(CHUNK, dtype=jnp.int32)[None, :, None]
    ik = jnp.arange(CHUNK, dtype=jnp.int32)[None, None, :]
    rel = (N_PREV - j) * CHUNK + iq - ik
    idx = jnp.clip(rel, -MAX_REL, MAX_REL) + MAX_REL
    bias = rel_table[idx]
    return jnp.transpose(bias, (3, 1, 0, 2))[:, None]


def chunk_band_attention(q, k, v, q_g, k_g, rel_table):
    bsz, s, h, dh = q.shape
    nc = s // CHUNK
    q = rms_norm(q, q_g) * (dh ** -0.5)
    k = rms_norm(k, k_g)
    qc = q.reshape(bsz, nc, CHUNK, h, dh)
    pad = ((0, 0), (N_PREV, 0), (0, 0), (0, 0), (0, 0))
    kp = jnp.pad(k.reshape(bsz, nc, CHUNK, h, dh), pad)
    vp = jnp.pad(v.reshape(bsz, nc, CHUNK, h, dh), pad)
    scores = jnp.stack([jnp.einsum('bnqhd,bnkhd->bhnqk', qc, kp[:, j:j + nc])
                        for j in range(N_BAND)], axis=4).astype(jnp.float32)
    scores = scores + relative_bias(rel_table).astype(jnp.float32)
    valid = (jnp.arange(nc)[:, None] - N_PREV + jnp.arange(N_BAND)[None, :]) >= 0
    scores = jnp.where(valid.reshape(1, 1, nc, 1, N_BAND, 1), scores, -1e30)
    p = jax.nn.softmax(scores.reshape(bsz, h, nc, CHUNK, N_BAND * CHUNK), axis=-1)
    p = p.reshape(bsz, h, nc, CHUNK, N_BAND, CHUNK).astype(v.dtype)
    out = jnp.einsum('bhnqk,bnkhd->bnqhd', p[:, :, :, :, 0], vp[:, 0:nc])
    for j in range(1, N_BAND):
        out = out + jnp.einsum('bhnqk,bnkhd->bnqhd', p[:, :, :, :, j], vp[:, j:j + nc])
    return out.reshape(bsz, s, h * dh)


def memory_attention(q, mk, mv, q_g, k_g):
    bsz, s, h, dh = q.shape
    q = rms_norm(q, q_g) * (dh ** -0.5)
    mk = rms_norm(mk, k_g)
    sc = jnp.einsum('bshd,bmhd->bhsm', q, mk).astype(jnp.float32)
    p = jax.nn.softmax(sc, axis=-1).astype(mv.dtype)
    return jnp.einsum('bhsm,bmhd->bshd', p, mv).reshape(bsz, s, h * dh)


def setup_inputs(seed: int = 0) -> dict:
    key = jax.random.key(seed)
    ks = jax.random.split(key, 20)
    f32 = jnp.float32
    nrm = lambda k, shape, scale: jax.random.normal(k, shape, f32) * scale
    return {
        "x": nrm(ks[0], (BATCH, SEQ, D_MODEL), 1.0),
        "mem": nrm(ks[1], (BATCH, MEM_LEN, D_MODEL), 1.0),
        "norm_g": 1.0 + nrm(ks[2], (DEPTH, D_MODEL), 0.02),
        "w_in": nrm(ks[3], (DEPTH, D_MODEL, N_IN), D_MODEL ** -0.5),
        "b_gate": nrm(ks[4], (DEPTH, N_BRANCH, D_MODEL), 0.02),
        "conv_w": nrm(ks[5], (DEPTH, CONV_WIDTH, W_A), CONV_WIDTH ** -0.5),
        "q_norm_g": 1.0 + nrm(ks[6], (DEPTH, HEAD_DIM), 0.02),
        "k_norm_g": 1.0 + nrm(ks[7], (DEPTH, HEAD_DIM), 0.02),
        "rel_table": nrm(ks[8], (DEPTH, 2 * MAX_REL + 1, H_B), 0.5),
        "mem_norm_g": 1.0 + nrm(ks[9], (DEPTH, D_MODEL), 0.02),
        "w_mem_kv": nrm(ks[10], (DEPTH, D_MODEL, 2 * W_M), D_MODEL ** -0.5),
        "mq_norm_g": 1.0 + nrm(ks[11], (DEPTH, HEAD_DIM), 0.02),
        "mk_norm_g": 1.0 + nrm(ks[12], (DEPTH, HEAD_DIM), 0.02),
        "w_branch_a": nrm(ks[13], (DEPTH, W_A, D_MODEL), W_A ** -0.5),
        "w_branch_b": nrm(ks[14], (DEPTH, W_B, D_MODEL), W_B ** -0.5),
        "w_branch_m": nrm(ks[15], (DEPTH, W_M, D_MODEL), W_M ** -0.5),
        "w_out": nrm(ks[16], (DEPTH, D_MODEL, D_MODEL), (2.0 * DEPTH * D_MODEL) ** -0.5),
    }


def reference(x, mem, norm_g, w_in, b_gate, conv_w, q_norm_g, k_norm_g, rel_table,
              mem_norm_g, w_mem_kv, mq_norm_g, mk_norm_g, w_branch_a, w_branch_b,
              w_branch_m, w_out):
    bsz, s, _ = x.shape
    offsets = np.cumsum(SPLIT_SIZES)[:-1].tolist()
    for l in range(DEPTH):
        h = rms_norm(x, norm_g[l])
        proj = h @ w_in[l]
        (a_b, a_c, a_x, a_z, q, k, v, b_z, mq, m_z,
         g_a, g_b, g_m) = jnp.split(proj, offsets, axis=-1)

        ya = short_conv_mixer(a_b, a_c, a_x, conv_w[l]) * jax.nn.silu(a_z)
        ya = ya @ w_branch_a[l]

        yb = chunk_band_attention(q.reshape(bsz, s, H_B, HEAD_DIM),
                                  k.reshape(bsz, s, H_B, HEAD_DIM),
                                  v.reshape(bsz, s, H_B, HEAD_DIM),
                                  q_norm_g[l], k_norm_g[l], rel_table[l])
        yb = (yb * jax.nn.silu(b_z)) @ w_branch_b[l]

        mkv = rms_norm(mem, mem_norm_g[l]) @ w_mem_kv[l]
        mk, mv = jnp.split(mkv, 2, axis=-1)
        ym = memory_attention(mq.reshape(bsz, s, H_M, HEAD_DIM),
                              mk.reshape(bsz, MEM_LEN, H_M, HEAD_DIM),
                              mv.reshape(bsz, MEM_LEN, H_M, HEAD_DIM),
                              mq_norm_g[l], mk_norm_g[l])
        ym = (ym * jax.nn.silu(m_z)) @ w_branch_m[l]

        merged = (jax.nn.sigmoid(g_a + b_gate[l, 0]) * ya
                  + jax.nn.sigmoid(g_b + b_gate[l, 1]) * yb
                  + jax.nn.sigmoid(g_m + b_gate[l, 2]) * ym)
        x = x + merged @ w_out[l]
    return x
```

```cpp
#include <hip/hip_runtime.h>
#include <hip/hip_cooperative_groups.h>
#include <cstdio>
#include <cstdint>
namespace cg = cooperative_groups;

#define LAS __attribute__((address_space(3)))
typedef unsigned short bf16_t;
typedef short bf16x8 __attribute__((ext_vector_type(8)));
typedef short s16x4 __attribute__((ext_vector_type(4)));
typedef float f32x4 __attribute__((ext_vector_type(4)));
typedef float f32x16 __attribute__((ext_vector_type(16)));
typedef unsigned u32x4 __attribute__((ext_vector_type(4)));
typedef unsigned u32x2 __attribute__((ext_vector_type(2)));
typedef float f32x2_t __attribute__((ext_vector_type(2)));
typedef __bf16 bf16x2_t __attribute__((ext_vector_type(2)));

constexpr int D_MODEL = 2048, BATCH = 8, SEQ = 4096, DEPTH = 2, CHUNK = 64, MEM_LEN = 256, HEAD_DIM = 128;
constexpr int W_A = 512, W_B = 1024, W_M = 512, H_B = 8, H_M = 4, N_IN = 13312;
constexpr int MTOK = BATCH * SEQ;
constexpr int MHALF = MTOK / 2;
constexpr int MMEM = BATCH * MEM_LEN;
constexpr float EPS = 1e-6f;
constexpr float LOG2E = 1.4426950408889634f;
constexpr int C_AB = 0, C_AC = 512, C_AX = 1024, C_AZ = 1536, C_Q = 2048, C_K = 3072, C_V = 4096, C_BZ = 5120, C_MQ = 6144, C_MZ = 6656, C_GA = 7168, C_GB = 9216, C_GM = 11264;

__device__ __forceinline__ unsigned pk2(float lo, float hi) { f32x2_t v = {lo, hi}; bf16x2_t b = __builtin_convertvector(v, bf16x2_t); return __builtin_bit_cast(unsigned, b); }
__device__ __forceinline__ float bflo(unsigned w) { return __uint_as_float(w << 16); }
__device__ __forceinline__ float bfhi(unsigned w) { return __uint_as_float(w & 0xffff0000u); }
__device__ __forceinline__ float sigmoidf_(float v) { return __builtin_amdgcn_rcpf(1.0f + __builtin_amdgcn_exp2f(-v * LOG2E)); }
__device__ __forceinline__ float wave_sum(float v) {
#pragma unroll
    for (int o = 1; o < 64; o <<= 1) v += __shfl_xor(v, o);
    return v;
}

namespace pg8 {
constexpr int BM = 256, BK = 64, HALF = 128, HTB = HALF * BK * 2, STAGE_BYTES = 8 * HTB, NXCD = 8, WGM = 8;
__host__ __device__ __forceinline__ int lds_byte(int r, int c) { const int st = (r >> 4) * 2 + (c >> 5), rr = r & 15, cc = c & 31, ob = rr * 64 + cc * 2; return st * 1024 + (ob ^ (((ob >> 9) & 1) << 5)); }
__host__ __device__ __forceinline__ void stage_rc(int b, int& R, int& C) { const int st = b / 1024, sb = b % 1024, swz = sb ^ (((sb >> 9) & 1) << 5); R = (st >> 1) * 16 + swz / 64; C = (st & 1) * 32 + (swz % 64) / 2; }
__host__ __device__ __forceinline__ int perm32(int rho) { const int n = rho >> 4, i = rho & 15; return 8 * (i >> 2) + 4 * n + (i & 3); }

struct Unit { int pm, pn; };
struct Gemm { const bf16_t* A; const bf16_t* Bt; int M, N, K, lda, ldb; };

struct StaticOrder {
    int nM, nN, nwg, G, c;
    __device__ void init(int M, int N, int G_, int c_) { nM = M / BM; nN = N / BM; nwg = nM * nN; G = G_; c = c_; }
    __device__ bool next(int i, Unit& u) const {
        const long L = (long)i * G + c; if (L >= nwg) return false;
        int wgid = (int)L; { const int q = nwg / NXCD, r = nwg % NXCD, xcd = wgid % NXCD, off = wgid / NXCD; wgid = (xcd < r ? xcd * (q + 1) : r * (q + 1) + (xcd - r) * q) + off; }
        const int nig = WGM * nN, gid = wgid / nig, fm = gid * WGM, gsz = (nM - fm) < WGM ? (nM - fm) : WGM;
        u.pm = fm + ((wgid % nig) % gsz); u.pn = (wgid % nig) / gsz; return true;
    }
};

struct EpiBf16 {
    static constexpr bool PERM = true;
    bf16_t* O; int ldc;
    __device__ __forceinline__ void operator()(const f32x4 (&acc)[2][2][4][2], const Unit& u, int wr, int wc, int fr, int fq) const {
        const int row0 = u.pm * BM + wr * 64 + fr, col0 = u.pn * BM + wc * 32 + 8 * fq;
#pragma unroll
        for (int ai = 0; ai < 2; ++ai)
#pragma unroll
            for (int m = 0; m < 4; ++m) { bf16_t* rowp = O + (size_t)(row0 + ai * HALF + m * 16) * ldc + col0;
#pragma unroll
                for (int bj = 0; bj < 2; ++bj) { const f32x4 v0 = acc[ai][bj][m][0], v1 = acc[ai][bj][m][1];
                    u32x4 w; w.x = pk2(v0[0], v0[1]); w.y = pk2(v0[2], v0[3]); w.z = pk2(v1[0], v1[1]); w.w = pk2(v1[2], v1[3]);
                    *(u32x4*)(rowp + bj * HALF) = w; } }
    }
};
struct EpiProj {
    static constexpr bool PERM = true;
    bf16_t* O; int ldc; const float* bgate;
    __device__ __forceinline__ void operator()(const f32x4 (&acc)[2][2][4][2], const Unit& u, int wr, int wc, int fr, int fq) const {
        const int colt = u.pn * BM;
        int mode = 0;
        if (colt >= C_GA) mode = 2; else if ((colt >= C_AZ && colt < C_Q) || (colt >= C_BZ && colt < C_MQ) || (colt >= C_MZ)) mode = 1;
        const int row0 = u.pm * BM + wr * 64 + fr, col0 = colt + wc * 32 + 8 * fq;
        f32x4 bv[2][2];
#pragma unroll
        for (int bj = 0; bj < 2; ++bj)
#pragma unroll
            for (int n = 0; n < 2; ++n) bv[bj][n] = (mode == 2) ? *(const f32x4*)(bgate + (col0 - C_GA) + bj * HALF + 4 * n) : (f32x4){0.f, 0.f, 0.f, 0.f};
#pragma unroll
        for (int ai = 0; ai < 2; ++ai)
#pragma unroll
            for (int m = 0; m < 4; ++m) { bf16_t* rowp = O + (size_t)(row0 + ai * HALF + m * 16) * ldc + col0;
#pragma unroll
                for (int bj = 0; bj < 2; ++bj) { f32x4 v0 = acc[ai][bj][m][0] + bv[bj][0], v1 = acc[ai][bj][m][1] + bv[bj][1];
                    if (mode != 0) {
#pragma unroll
                        for (int e = 0; e < 4; ++e) { const float s0 = sigmoidf_(v0[e]), s1 = sigmoidf_(v1[e]); v0[e] = (mode == 1) ? v0[e] * s0 : s0; v1[e] = (mode == 1) ? v1[e] * s1 : s1; }
                    }
                    u32x4 w; w.x = pk2(v0[0], v0[1]); w.y = pk2(v0[2], v0[3]); w.z = pk2(v1[0], v1[1]); w.w = pk2(v1[2], v1[3]);
                    *(u32x4*)(rowp + bj * HALF) = w; } }
    }
};
template <int PASS> struct EpiGate {
    static constexpr bool PERM = true;
    const bf16_t* G; bf16_t* MG; bf16_t* OUT;
    __device__ __forceinline__ void operator()(const f32x4 (&acc)[2][2][4][2], const Unit& u, int wr, int wc, int fr, int fq) const {
        const int row0 = u.pm * BM + wr * 64 + fr, col0 = u.pn * BM + wc * 32 + 8 * fq;
        const unsigned pb = (unsigned)(row0 * N_IN + col0) * 2u, ob = (unsigned)(row0 * D_MODEL + col0) * 2u;
#pragma unroll
        for (int ai = 0; ai < 2; ++ai)
#pragma unroll
            for (int m = 0; m < 4; ++m) {
#pragma unroll
                for (int bj = 0; bj < 2; ++bj) { const unsigned off = pb + (unsigned)((ai * HALF + m * 16) * N_IN + bj * HALF) * 2u;
                    const u32x4 g = *(const u32x4*)((const char*)G + off);
                    const f32x4 a0 = acc[ai][bj][m][0], a1 = acc[ai][bj][m][1];
                    float v[8];
                    v[0] = bflo(g.x) * a0[0]; v[1] = bfhi(g.x) * a0[1]; v[2] = bflo(g.y) * a0[2]; v[3] = bfhi(g.y) * a0[3];
                    v[4] = bflo(g.z) * a1[0]; v[5] = bfhi(g.z) * a1[1]; v[6] = bflo(g.w) * a1[2]; v[7] = bfhi(g.w) * a1[3];
                    if (PASS > 0) { const u32x4 p = *(const u32x4*)((const char*)MG + off);
                        v[0] += bflo(p.x); v[1] += bfhi(p.x); v[2] += bflo(p.y); v[3] += bfhi(p.y); v[4] += bflo(p.z); v[5] += bfhi(p.z); v[6] += bflo(p.w); v[7] += bfhi(p.w); }
                    u32x4 w; w.x = pk2(v[0], v[1]); w.y = pk2(v[2], v[3]); w.z = pk2(v[4], v[5]); w.w = pk2(v[6], v[7]);
                    if (PASS < 2) *(u32x4*)((char*)MG + off) = w; else *(u32x4*)((char*)OUT + ob + (unsigned)((ai * HALF + m * 16) * D_MODEL + bj * HALF) * 2u) = w; }
                asm volatile("" ::: "memory"); }
    }
};
struct EpiResid {
    static constexpr bool PERM = false;
    const float* base; float* out; int ldc;
    __device__ __forceinline__ void operator()(const f32x4 (&acc)[2][2][4][2], const Unit& u, int wr, int wc, int fr, int fq) const {
        const int row0 = u.pm * BM + wr * 64 + fr, col0 = u.pn * BM + wc * 32 + 4 * fq;
#pragma unroll
        for (int ai = 0; ai < 2; ++ai)
#pragma unroll
            for (int m = 0; m < 4; ++m) { const size_t off = (size_t)(row0 + ai * HALF + m * 16) * ldc + col0;
#pragma unroll
                for (int bj = 0; bj < 2; ++bj)
#pragma unroll
                    for (int n = 0; n < 2; ++n) { const f32x4 b = *(const f32x4*)(base + off + bj * HALF + n * 16); *(f32x4*)(out + off + bj * HALF + n * 16) = b + acc[ai][bj][m][n]; }
                asm volatile("" ::: "memory"); }
    }
};

template <class Epi>
__device__ __forceinline__ void gemm_phase(LAS unsigned char* lds, const Gemm g, const StaticOrder& S, const Epi& E) {
    int tid_ = threadIdx.x; asm volatile("" : "+v"(tid_));
    const int tid = tid_, wid = __builtin_amdgcn_readfirstlane(tid >> 6), lane = tid & 63, wr = wid >> 2, wc = wid & 3, fr = lane & 15, fq = lane >> 4;
    const int K = g.K, nt = K / BK;
    unsigned voffA[2], voffB[2];
#pragma unroll
    for (int i = 0; i < 2; ++i) { int R, C; stage_rc(tid * 16 + i * 8192, R, C); const int Rb = Epi::PERM ? ((R & ~31) + perm32(R & 31)) : R;
        voffA[i] = (unsigned)(R * g.lda + C) * 2u; voffB[i] = (unsigned)(Rb * g.ldb + C) * 2u; }
    const size_t kstep = (size_t)(BK * 2);
    const size_t hA = (size_t)HALF * g.lda * 2, hB = (size_t)HALF * g.ldb * 2;
    const size_t tA = 2 * hA, tB = 2 * hB;
    const unsigned ldsw = (unsigned)wid * 1024u;
    const int aoff = lds_byte(wr * 64 + fr, fq * 8), boff = lds_byte(wc * 32 + fr, fq * 8);
#define PG8_SA(b, h) (((b) * 2 + (h)) * HTB)
#define PG8_SB(b, h) ((4 + (b) * 2 + (h)) * HTB)
#define PG8_STAGE(bufoff, gbase, voff) do { _Pragma("unroll") for (int _i = 0; _i < 2; ++_i) \
        __builtin_amdgcn_global_load_lds((const unsigned*)((const char*)(gbase) + (voff)[_i]), (LAS unsigned*)(lds + (bufoff) + ldsw + _i * 8192), 16, 0, 0); } while (0)
#define PG8_LDA(dst, b, h) do { _Pragma("unroll") for (int m = 0; m < 4; ++m) _Pragma("unroll") for (int k = 0; k < 2; ++k) dst[m][k] = *(const LAS bf16x8*)(lds + PG8_SA(b, h) + aoff + m * 2048 + k * 1024); } while (0)
#define PG8_LDB(dst, b, h) do { _Pragma("unroll") for (int n = 0; n < 2; ++n) _Pragma("unroll") for (int k = 0; k < 2; ++k) dst[n][k] = *(const LAS bf16x8*)(lds + PG8_SB(b, h) + boff + n * 2048 + k * 1024); } while (0)
#define PG8_MMA(ai, bj, At, Bt) do { __builtin_amdgcn_s_setprio(1); _Pragma("unroll") for (int m = 0; m < 4; ++m) _Pragma("unroll") for (int n = 0; n < 2; ++n) _Pragma("unroll") for (int k = 0; k < 2; ++k) \
        acc[ai][bj][m][n] = __builtin_amdgcn_mfma_f32_16x16x32_bf16(Bt[n][k], At[m][k], acc[ai][bj][m][n], 0, 0, 0); __builtin_amdgcn_s_setprio(0); } while (0)
#define PG8_WAIT_V(n) asm volatile("s_waitcnt vmcnt(" #n ")" ::: "memory")
#define PG8_WAIT_L(n) asm volatile("s_waitcnt lgkmcnt(" #n ")" ::: "memory")
#define PG8_BAR __builtin_amdgcn_s_barrier()
#define PG8_SCHED __builtin_amdgcn_sched_barrier(0)
    Unit cur, nxt; int ui = 0;
    if (!S.next(0, cur)) return;
    f32x4 acc[2][2][4][2];
#pragma unroll
    for (int a = 0; a < 2; ++a)
#pragma unroll
        for (int b = 0; b < 2; ++b)
#pragma unroll
            for (int m = 0; m < 4; ++m)
#pragma unroll
                for (int n = 0; n < 2; ++n) acc[a][b][m][n] = (f32x4){0.f, 0.f, 0.f, 0.f};
    bf16x8 At[4][2], B0[2][2], B1[2][2];
    const char* cA = (const char*)g.A + (size_t)cur.pm * tA; const char* cB = (const char*)g.Bt + (size_t)cur.pn * tB;
    PG8_STAGE(PG8_SB(0, 0), cB, voffB); PG8_STAGE(PG8_SB(0, 1), cB + hB, voffB); PG8_STAGE(PG8_SA(0, 0), cA, voffA); PG8_STAGE(PG8_SA(0, 1), cA + hA, voffA);
    if (wr == 1) PG8_BAR;
    PG8_WAIT_V(2); PG8_BAR;
    PG8_STAGE(PG8_SB(1, 0), cB + kstep, voffB); PG8_STAGE(PG8_SA(1, 0), cA + kstep, voffA); PG8_STAGE(PG8_SB(1, 1), cB + hB + kstep, voffB);
    PG8_WAIT_V(6); PG8_BAR;
    for (;;) {
        const bool has_next = S.next(ui + 1, nxt);
        const char* nA = has_next ? (const char*)g.A + (size_t)nxt.pm * tA : cA; const char* nB = has_next ? (const char*)g.Bt + (size_t)nxt.pn * tB : cB;
        for (int t = 0; t < nt; t += 2) {
            const bool last = (t == nt - 2);
            const char* a1 = cA + (size_t)(t + 1) * kstep;
            const char* a2 = last ? nA : cA + (size_t)(t + 2) * kstep; const char* b2 = last ? nB : cB + (size_t)(t + 2) * kstep;
            const char* a3 = a2 + kstep; const char* b3 = b2 + kstep;
            PG8_LDB(B0, 0, 0); PG8_LDB(B1, 0, 1); PG8_SCHED; PG8_LDA(At, 0, 0); PG8_STAGE(PG8_SA(1, 1), a1 + hA, voffA);
            PG8_WAIT_V(8); PG8_WAIT_L(0); PG8_BAR; PG8_MMA(0, 0, At, B0); PG8_MMA(0, 1, At, B1); PG8_BAR; PG8_SCHED;
            PG8_LDA(At, 0, 1); PG8_STAGE(PG8_SB(0, 0), b2, voffB); PG8_STAGE(PG8_SB(0, 1), b2 + hB, voffB); PG8_STAGE(PG8_SA(0, 0), a2, voffA);
            PG8_WAIT_V(8); PG8_WAIT_L(0); PG8_BAR; PG8_MMA(1, 0, At, B0); PG8_MMA(1, 1, At, B1); PG8_BAR; PG8_SCHED;
            PG8_LDB(B0, 1, 0); PG8_LDB(B1, 1, 1); PG8_SCHED; PG8_LDA(At, 1, 0); PG8_STAGE(PG8_SA(0, 1), a2 + hA, voffA);
            PG8_WAIT_V(8); PG8_WAIT_L(0); PG8_BAR; PG8_MMA(0, 0, At, B0); PG8_MMA(0, 1, At, B1); PG8_BAR; PG8_SCHED;
            PG8_LDA(At, 1, 1); PG8_STAGE(PG8_SB(1, 0), b3, voffB); PG8_STAGE(PG8_SB(1, 1), b3 + hB, voffB); PG8_STAGE(PG8_SA(1, 0), a3, voffA);
            PG8_WAIT_V(8); PG8_WAIT_L(0); PG8_BAR; PG8_MMA(1, 0, At, B0); PG8_MMA(1, 1, At, B1); PG8_BAR; PG8_SCHED;
        }
        if (wr == 0) PG8_BAR;
        E(acc, cur, wr, wc, fr, fq);
        if (!has_next) break;
#pragma unroll
        for (int a = 0; a < 2; ++a)
#pragma unroll
            for (int b = 0; b < 2; ++b)
#pragma unroll
                for (int m = 0; m < 4; ++m)
#pragma unroll
                    for (int n = 0; n < 2; ++n) acc[a][b][m][n] = (f32x4){0.f, 0.f, 0.f, 0.f};
        cur = nxt; cA = nA; cB = nB; ++ui;
        if (wr == 1) PG8_BAR;
    }
    PG8_WAIT_V(0);
    PG8_BAR;
#undef PG8_SA
#undef PG8_SB
#undef PG8_STAGE
#undef PG8_LDA
#undef PG8_LDB
#undef PG8_MMA
#undef PG8_WAIT_V
#undef PG8_WAIT_L
#undef PG8_BAR
#undef PG8_SCHED
}
}

namespace at {
constexpr int KSTR = 272, VSTR = 320;
constexpr int AT_K = 0, AT_V = 2 * 64 * KSTR, AT_TAB = AT_V + 2 * 64 * VSTR, AT_END = AT_TAB + 640 * 4;
__device__ __forceinline__ s16x4 vtr(const LAS unsigned char* p) { return __builtin_bit_cast(s16x4, __builtin_amdgcn_ds_read_tr16_b64_v4i16((LAS s16x4*)p)); }

template <bool CH>
__device__ __forceinline__ void attn_unit(LAS unsigned char* lds, bf16_t* QO, const bf16_t* SZ, int ldq, const bf16_t* Kb, const bf16_t* Vb, int ldk,
                                          int q_row0, int k_row0, int jstart, int ntiles, const float* gq, const float* gk, const float* rel) {
    int tid_ = threadIdx.x; asm volatile("" : "+v"(tid_));
    const int tid = tid_, lane = tid & 63, w = __builtin_amdgcn_readfirstlane(tid >> 6), r32 = lane & 31, hh = lane >> 5;
    LAS float* tab = (LAS float*)(lds + AT_TAB);
    if (CH) { for (int e = tid; e < 640; e += 512) { int idx = e - 63; idx = idx < -256 ? -256 : (idx > 256 ? 256 : idx); tab[e] = rel[(idx + 256) * 8] * LOG2E; } }
    const int qrow = q_row0 + 32 * w + r32;
    bf16x8 qf[8];
    {
        const bf16_t* qp = QO + (size_t)qrow * ldq + 8 * hh;
        u32x4 qraw[8];
#pragma unroll
        for (int ds = 0; ds < 8; ++ds) qraw[ds] = *(const u32x4*)(qp + 16 * ds);
        float ss = 0.f;
#pragma unroll
        for (int ds = 0; ds < 8; ++ds)
#pragma unroll
            for (int k = 0; k < 4; ++k) { const float a = bflo(qraw[ds][k]), b = bfhi(qraw[ds][k]); ss += a * a + b * b; }
        ss += __shfl_xor(ss, 32);
        const float rs = rsqrtf(ss * (1.0f / 128.0f) + EPS) * (0.08838834764831845f * LOG2E);
#pragma unroll
        for (int ds = 0; ds < 8; ++ds) {
            const f32x4 g0 = *(const f32x4*)(gq + 16 * ds + 8 * hh), g1 = *(const f32x4*)(gq + 16 * ds + 8 * hh + 4);
            u32x4 o;
            o.x = pk2(bflo(qraw[ds].x) * rs * g0[0], bfhi(qraw[ds].x) * rs * g0[1]); o.y = pk2(bflo(qraw[ds].y) * rs * g0[2], bfhi(qraw[ds].y) * rs * g0[3]);
            o.z = pk2(bflo(qraw[ds].z) * rs * g1[0], bfhi(qraw[ds].z) * rs * g1[1]); o.w = pk2(bflo(qraw[ds].w) * rs * g1[2], bfhi(qraw[ds].w) * rs * g1[3]);
            qf[ds] = __builtin_bit_cast(bf16x8, o);
        }
    }
    const int srow = tid >> 4, sc = tid & 15;
    const f32x4 gk0 = *(const f32x4*)(gk + 8 * sc), gk1 = *(const f32x4*)(gk + 8 * sc + 4);
    u32x4 kr[2], vr[2];
#define AT_GLOAD(j) do { const size_t ro_ = (size_t)(k_row0 + (j) * 64 + srow) * ldk + 8 * sc; \
        kr[0] = *(const u32x4*)(Kb + ro_); kr[1] = *(const u32x4*)(Kb + ro_ + (size_t)32 * ldk); vr[0] = *(const u32x4*)(Vb + ro_); vr[1] = *(const u32x4*)(Vb + ro_ + (size_t)32 * ldk); } while (0)
#define AT_SSTORE(buf) do { _Pragma("unroll") for (int i_ = 0; i_ < 2; ++i_) { const u32x4 kq = kr[i_]; \
        float s_ = bflo(kq.x) * bflo(kq.x) + bfhi(kq.x) * bfhi(kq.x) + bflo(kq.y) * bflo(kq.y) + bfhi(kq.y) * bfhi(kq.y) + bflo(kq.z) * bflo(kq.z) + bfhi(kq.z) * bfhi(kq.z) + bflo(kq.w) * bflo(kq.w) + bfhi(kq.w) * bfhi(kq.w); \
        s_ += __shfl_xor(s_, 1); s_ += __shfl_xor(s_, 2); s_ += __shfl_xor(s_, 4); s_ += __shfl_xor(s_, 8); \
        const float rk_ = rsqrtf(s_ * (1.0f / 128.0f) + EPS); u32x4 kn; \
        kn.x = pk2(bflo(kq.x) * rk_ * gk0[0], bfhi(kq.x) * rk_ * gk0[1]); kn.y = pk2(bflo(kq.y) * rk_ * gk0[2], bfhi(kq.y) * rk_ * gk0[3]); \
        kn.z = pk2(bflo(kq.z) * rk_ * gk1[0], bfhi(kq.z) * rk_ * gk1[1]); kn.w = pk2(bflo(kq.w) * rk_ * gk1[2], bfhi(kq.w) * rk_ * gk1[3]); \
        *(LAS u32x4*)(lds + AT_K + (buf) * (64 * KSTR) + (srow + 32 * i_) * KSTR + 16 * sc) = kn; \
        *(LAS u32x4*)(lds + AT_V + (buf) * (64 * VSTR) + (srow + 32 * i_) * VSTR + 16 * sc) = vr[i_]; } } while (0)

    float mrun = -1e30f, lsum = 0.f;
    f32x16 o[4];
#pragma unroll
    for (int db = 0; db < 4; ++db)
#pragma unroll
        for (int i = 0; i < 16; ++i) o[db][i] = 0.f;
    AT_GLOAD(jstart); AT_SSTORE(0); __syncthreads();
#pragma unroll 1
    for (int j = jstart; j < ntiles; ++j) {
        const int buf = (j - jstart) & 1;
        const bool more = (j + 1 < ntiles);
        if (more) AT_GLOAD(j + 1);
        const int jj = j - (w >> 1);
        if (!CH || (jj >= 0 && jj <= 8)) {
            const LAS unsigned char* Kt = lds + AT_K + buf * (64 * KSTR) + r32 * KSTR + 16 * hh;
            f32x16 p0, p1;
            float init = 0.f; if (CH && jj <= 3) init = tab[638];
#pragma unroll
            for (int i = 0; i < 16; ++i) { p0[i] = init; p1[i] = init; }
#pragma unroll
            for (int ds = 0; ds < 8; ++ds) {
                const bf16x8 a0 = *(const LAS bf16x8*)(Kt + 32 * ds), a1 = *(const LAS bf16x8*)(Kt + 32 * KSTR + 32 * ds);
                p0 = __builtin_amdgcn_mfma_f32_32x32x16_bf16(a0, qf[ds], p0, 0, 0, 0);
                p1 = __builtin_amdgcn_mfma_f32_32x32x16_bf16(a1, qf[ds], p1, 0, 0, 0);
            }
            if (CH && jj >= 4) {
                const LAS float* tb = tab + ((8 - jj) * 64 + 32 * (w & 1) + r32 - 4 * hh);
#pragma unroll
                for (int i = 0; i < 16; ++i) { p0[i] += tb[63 - (i & 3) - 8 * (i >> 2)]; p1[i] += tb[31 - (i & 3) - 8 * (i >> 2)]; }
            }
            float rm = fmaxf(p0[0], p1[0]);
#pragma unroll
            for (int i = 1; i < 16; ++i) rm = fmaxf(rm, fmaxf(p0[i], p1[i]));
            rm = fmaxf(rm, __shfl_xor(rm, 32));
            const float mn = fmaxf(mrun, rm);
            const float alpha = __builtin_amdgcn_exp2f(mrun - mn);
            mrun = mn;
            float ps = 0.f;
#pragma unroll
            for (int i = 0; i < 16; ++i) { p0[i] = __builtin_amdgcn_exp2f(p0[i] - mn); p1[i] = __builtin_amdgcn_exp2f(p1[i] - mn); ps += p0[i] + p1[i]; }
            lsum = lsum * alpha + ps;
#pragma unroll
            for (int db = 0; db < 4; ++db)
#pragma unroll
                for (int i = 0; i < 16; ++i) o[db][i] *= alpha;
            bf16x8 pf[2][2];
#pragma unroll
            for (int s = 0; s < 2; ++s) {
                u32x4 a, b;
                a.x = pk2(p0[8 * s + 0], p0[8 * s + 1]); a.y = pk2(p0[8 * s + 2], p0[8 * s + 3]); a.z = pk2(p0[8 * s + 4], p0[8 * s + 5]); a.w = pk2(p0[8 * s + 6], p0[8 * s + 7]);
                b.x = pk2(p1[8 * s + 0], p1[8 * s + 1]); b.y = pk2(p1[8 * s + 2], p1[8 * s + 3]); b.z = pk2(p1[8 * s + 4], p1[8 * s + 5]); b.w = pk2(p1[8 * s + 6], p1[8 * s + 7]);
                pf[0][s] = __builtin_bit_cast(bf16x8, a); pf[1][s] = __builtin_bit_cast(bf16x8, b);
            }
            const LAS unsigned char* Vt = lds + AT_V + buf * (64 * VSTR) + (4 * hh + ((lane & 15) >> 2)) * VSTR + (16 * ((lane >> 4) & 1) + 4 * (lane & 3)) * 2;
#pragma unroll
            for (int db = 0; db < 4; ++db)
#pragma unroll
                for (int kb = 0; kb < 2; ++kb)
#pragma unroll
                    for (int s = 0; s < 2; ++s) {
                        const s16x4 lo = vtr(Vt + (kb * 32 + 16 * s) * VSTR + 64 * db), hi = vtr(Vt + (kb * 32 + 16 * s + 8) * VSTR + 64 * db);
                        const bf16x8 vf = __builtin_shufflevector(lo, hi, 0, 1, 2, 3, 4, 5, 6, 7);
                        o[db] = __builtin_amdgcn_mfma_f32_32x32x16_bf16(vf, pf[kb][s], o[db], 0, 0, 0);
                    }
        }
        if (more) AT_SSTORE(buf ^ 1);
        __syncthreads();
    }
#undef AT_GLOAD
#undef AT_SSTORE
    const float l = lsum + __shfl_xor(lsum, 32);
    const float inv = 1.0f / l;
    bf16_t* op = QO + (size_t)qrow * ldq + 4 * hh; const bf16_t* zp = SZ + (size_t)qrow * ldq + 4 * hh;
#pragma unroll
    for (int db = 0; db < 4; ++db)
#pragma unroll
        for (int g = 0; g < 4; ++g) {
            const int d = 32 * db + 8 * g;
            const u32x2 z = *(const u32x2*)(zp + d);
            u32x2 r;
            r.x = pk2(o[db][4 * g + 0] * inv * bflo(z.x), o[db][4 * g + 1] * inv * bfhi(z.x));
            r.y = pk2(o[db][4 * g + 2] * inv * bflo(z.y), o[db][4 * g + 3] * inv * bfhi(z.y));
            *(u32x2*)(op + d) = r;
        }
}
}

constexpr int NWAVES = 8, NTHREADS = 512;
constexpr int LDS_BYTES = 147456;
constexpr size_t MiB = 1u << 20;
constexpr size_t SZ_WIN = (size_t)N_IN * D_MODEL * 2, SZ_WA = (size_t)D_MODEL * W_A * 2, SZ_WB = (size_t)D_MODEL * W_B * 2, SZ_WM = (size_t)D_MODEL * W_M * 2,
                 SZ_WO = (size_t)D_MODEL * D_MODEL * 2, SZ_WMEM = (size_t)(2 * W_M) * D_MODEL * 2;
constexpr size_t SZ_WL = SZ_WIN + SZ_WA + SZ_WB + SZ_WM + SZ_WO + SZ_WMEM;
constexpr size_t WS_W = 1 * MiB;
constexpr size_t WS_MEMN = WS_W + DEPTH * SZ_WL;
constexpr size_t WS_MKV = WS_MEMN + (size_t)DEPTH * MMEM * D_MODEL * 2;
constexpr size_t WS_H = WS_MKV + (size_t)DEPTH * MMEM * (2 * W_M) * 2;
constexpr size_t WS_MERGED = WS_H + (size_t)MTOK * D_MODEL * 2;
constexpr size_t WS_PROJ = WS_MERGED + (size_t)MHALF * D_MODEL * 2;
constexpr size_t WS_END = WS_PROJ + (size_t)MHALF * N_IN * 2;
static_assert(WS_END <= (size_t)1024 * MiB, "workspace map must fit 1 GiB");

__device__ __forceinline__ void p0_transpose_item(const float* W, int K, int N, bf16_t* WT, LAS float* scr, int item, int lane) {
    const int nblk = N / 32, kb = item / nblk, nb = item % nblk, k0 = 64 * kb, n0 = 32 * nb;
#pragma unroll 8
    for (int i = 0; i < 32; ++i) { const int kk = 2 * i + (lane >> 5); scr[kk * 33 + (lane & 31)] = W[(size_t)(k0 + kk) * N + n0 + (lane & 31)]; }
    asm volatile("s_waitcnt lgkmcnt(0)" ::: "memory");
    const int c = lane & 7;
#pragma unroll
    for (int j = 0; j < 4; ++j) { const int n = (lane >> 3) + 8 * j; const LAS float* s = scr + (8 * c) * 33 + n;
        u32x4 o; o.x = pk2(s[0 * 33], s[1 * 33]); o.y = pk2(s[2 * 33], s[3 * 33]); o.z = pk2(s[4 * 33], s[5 * 33]); o.w = pk2(s[6 * 33], s[7 * 33]);
        *(u32x4*)(WT + (size_t)(n0 + n) * K + k0 + 8 * c) = o; }
    asm volatile("s_waitcnt lgkmcnt(0)" ::: "memory");
}
__device__ __forceinline__ void rms_row_to_bf16(const float* xrow, const float* g, bf16_t* orow, int lane) {
    const f32x4* xr = (const f32x4*)xrow + lane; const f32x4* gr = (const f32x4*)g + lane;
    f32x4 v[8]; float s = 0.f;
#pragma unroll
    for (int j = 0; j < 8; ++j) { v[j] = xr[64 * j]; s += (v[j].x * v[j].x + v[j].y * v[j].y) + (v[j].z * v[j].z + v[j].w * v[j].w); }
    const float rstd = rsqrtf(wave_sum(s) * (1.f / D_MODEL) + EPS);
    u32x2* o8 = (u32x2*)orow + lane;
#pragma unroll
    for (int j = 0; j < 8; ++j) { const f32x4 gg = gr[64 * j]; u32x2 r; r.x = pk2(v[j].x * rstd * gg.x, v[j].y * rstd * gg.y); r.y = pk2(v[j].z * rstd * gg.z, v[j].w * rstd * gg.w); o8[64 * j] = r; }
}

struct Args { const float* in[17]; float* out; unsigned char* ws; };


__global__ void __launch_bounds__(NTHREADS, 2) fwd_megakernel(Args args) {
    extern __shared__ __attribute__((aligned(16))) unsigned char lds_raw[];
    LAS unsigned char* lds = (LAS unsigned char*)lds_raw;
    cg::grid_group grid = cg::this_grid();
    const int tid = threadIdx.x, lane = tid & 63, wave = __builtin_amdgcn_readfirstlane(tid >> 6);
    const int G = gridDim.x, bx = blockIdx.x;
    const int gw = bx * NWAVES + wave, NGW = G * NWAVES;
    unsigned char* ws = args.ws;
    float* out = args.out;
    bf16_t* Hb = (bf16_t*)(ws + WS_H); bf16_t* MERGED = (bf16_t*)(ws + WS_MERGED); bf16_t* PROJ = (bf16_t*)(ws + WS_PROJ);
    bf16_t* MEMN = (bf16_t*)(ws + WS_MEMN); bf16_t* MKV = (bf16_t*)(ws + WS_MKV);
#define WT_IN(l)  ((bf16_t*)(ws + WS_W + (size_t)(l) * SZ_WL))
#define WT_A(l)   ((bf16_t*)(ws + WS_W + (size_t)(l) * SZ_WL + SZ_WIN))
#define WT_B(l)   ((bf16_t*)(ws + WS_W + (size_t)(l) * SZ_WL + SZ_WIN + SZ_WA))
#define WT_M(l)   ((bf16_t*)(ws + WS_W + (size_t)(l) * SZ_WL + SZ_WIN + SZ_WA + SZ_WB))
#define WT_O(l)   ((bf16_t*)(ws + WS_W + (size_t)(l) * SZ_WL + SZ_WIN + SZ_WA + SZ_WB + SZ_WM))
#define WT_MEM(l) ((bf16_t*)(ws + WS_W + (size_t)(l) * SZ_WL + SZ_WIN + SZ_WA + SZ_WB + SZ_WM + SZ_WO))

    {
        LAS float* scr = (LAS float*)(lds + wave * 16384);
        constexpr int I_IN = (D_MODEL / 64) * (N_IN / 32), I_A = (W_A / 64) * (D_MODEL / 32), I_B = (W_B / 64) * (D_MODEL / 32), I_M = (W_M / 64) * (D_MODEL / 32),
                      I_O = (D_MODEL / 64) * (D_MODEL / 32), I_MEM = (D_MODEL / 64) * (2 * W_M / 32);
        constexpr int I_L = I_IN + I_A + I_B + I_M + I_O + I_MEM;
        for (int it = gw; it < DEPTH * I_L; it += NGW) {
            const int l = it / I_L; int r = it % I_L;
            if (r < I_IN) { p0_transpose_item(args.in[3] + (size_t)l * D_MODEL * N_IN, D_MODEL, N_IN, WT_IN(l), scr, r, lane); continue; } r -= I_IN;
            if (r < I_A) { p0_transpose_item(args.in[13] + (size_t)l * W_A * D_MODEL, W_A, D_MODEL, WT_A(l), scr, r, lane); continue; } r -= I_A;
            if (r < I_B) { p0_transpose_item(args.in[14] + (size_t)l * W_B * D_MODEL, W_B, D_MODEL, WT_B(l), scr, r, lane); continue; } r -= I_B;
            if (r < I_M) { p0_transpose_item(args.in[15] + (size_t)l * W_M * D_MODEL, W_M, D_MODEL, WT_M(l), scr, r, lane); continue; } r -= I_M;
            if (r < I_O) { p0_transpose_item(args.in[16] + (size_t)l * D_MODEL * D_MODEL, D_MODEL, D_MODEL, WT_O(l), scr, r, lane); continue; } r -= I_O;
            p0_transpose_item(args.in[10] + (size_t)l * D_MODEL * (2 * W_M), D_MODEL, 2 * W_M, WT_MEM(l), scr, r, lane);
        }
        for (int m = gw; m < DEPTH * MMEM; m += NGW) { const int l = m / MMEM, r = m % MMEM;
            rms_row_to_bf16(args.in[1] + (size_t)r * D_MODEL, args.in[9] + (size_t)l * D_MODEL, MEMN + (size_t)m * D_MODEL, lane); }
        for (int m = gw; m < MTOK; m += NGW) rms_row_to_bf16(args.in[0] + (size_t)m * D_MODEL, args.in[2], Hb + (size_t)m * D_MODEL, lane);
    }
    grid.sync();

    for (int it = 0; it <= 4; ++it) {
        const int l = (it >> 1) & 1, half = it & 1;
        if (it == 0) {
            for (int ll = 0; ll < DEPTH; ++ll) {
                pg8::Gemm g{MEMN + (size_t)ll * MMEM * D_MODEL, WT_MEM(ll), MMEM, 2 * W_M, D_MODEL, D_MODEL, D_MODEL};
                pg8::StaticOrder S; S.init(MMEM, 2 * W_M, G, (bx + 32 * ll) % G);
                pg8::EpiBf16 E{MKV + (size_t)ll * MMEM * (2 * W_M), 2 * W_M};
                pg8::gemm_phase<pg8::EpiBf16>(lds, g, S, E);
            }
        }
        if (it >= 1) {
            const int pl = ((it - 1) >> 1) & 1, ph = (it - 1) & 1;
            pg8::Gemm g{MERGED, WT_O(pl), MHALF, D_MODEL, D_MODEL, D_MODEL, D_MODEL};
            pg8::StaticOrder S; S.init(MHALF, D_MODEL, G, bx);
            const float* base = (pl == 0 ? args.in[0] : (const float*)out) + (size_t)ph * MHALF * D_MODEL;
            pg8::EpiResid E{base, out + (size_t)ph * MHALF * D_MODEL, D_MODEL};
            pg8::gemm_phase<pg8::EpiResid>(lds, g, S, E);
        }
        if (it == 4) break;
        {
            pg8::Gemm g{Hb + (size_t)half * MHALF * D_MODEL, WT_IN(l), MHALF, N_IN, D_MODEL, D_MODEL, D_MODEL};
            pg8::StaticOrder S; S.init(MHALF, N_IN, G, bx);
            pg8::EpiProj E{PROJ, N_IN, args.in[4] + (size_t)l * 3 * D_MODEL};
            pg8::gemm_phase<pg8::EpiProj>(lds, g, S, E);
        }
        grid.sync();
        {
            for (int u = bx; u < 4 * H_B * 16; u += G) {
                const int qb = u & 15, hd = (u >> 4) & 7, bb = u >> 7;
                const int n0 = 4 * qb, jstart = (8 - n0) > 0 ? (8 - n0) : 0;
                at::attn_unit<true>(lds, PROJ + C_Q + hd * HEAD_DIM, PROJ + C_BZ + hd * HEAD_DIM, N_IN, PROJ + C_K + hd * HEAD_DIM, PROJ + C_V + hd * HEAD_DIM, N_IN,
                                    bb * SEQ + qb * 256, bb * SEQ + (n0 - 8) * CHUNK, jstart, 12,
                                    args.in[6] + (size_t)l * HEAD_DIM, args.in[7] + (size_t)l * HEAD_DIM, args.in[8] + (size_t)l * 513 * H_B + hd);
            }
            for (int u = bx; u < 4 * H_M * 16; u += G) {
                const int qb = u & 15, hd = (u >> 4) & 3, bb = u >> 6;
                const bf16_t* kv = MKV + (size_t)l * MMEM * (2 * W_M) + hd * HEAD_DIM;
                at::attn_unit<false>(lds, PROJ + C_MQ + hd * HEAD_DIM, PROJ + C_MZ + hd * HEAD_DIM, N_IN, kv, kv + W_M, 2 * W_M,
                                     bb * SEQ + qb * 256, (half * 4 + bb) * MEM_LEN, 0, 4,
                                     args.in[11] + (size_t)l * HEAD_DIM, args.in[12] + (size_t)l * HEAD_DIM, args.in[8]);
            }
            {
                const float* cw = args.in[5] + (size_t)l * 3 * W_A + 8 * lane;
                f32x4 wv[3][2];
#pragma unroll
                for (int tp = 0; tp < 3; ++tp) { wv[tp][0] = *(const f32x4*)(cw + tp * W_A); wv[tp][1] = *(const f32x4*)(cw + tp * W_A + 4); }
                for (int r = gw; r < MHALF; r += NGW) {
                    const int t = r & (SEQ - 1);
                    bf16_t* base = PROJ + (size_t)r * N_IN + 8 * lane;
                    const u32x4 ab = *(const u32x4*)(base + C_AB), az = *(const u32x4*)(base + C_AZ);
                    float acc[8];
#pragma unroll
                    for (int k = 0; k < 8; ++k) acc[k] = 0.f;
#pragma unroll
                    for (int tp = 0; tp < 3; ++tp) {
                        const int dt = 2 - tp;
                        if (t >= dt) {
                            const bf16_t* pb = base - (size_t)dt * N_IN;
                            const u32x4 ac = *(const u32x4*)(pb + C_AC), ax = *(const u32x4*)(pb + C_AX);
#pragma unroll
                            for (int k = 0; k < 4; ++k) { acc[2 * k] += wv[tp][k >> 1][(2 * k) & 3] * bflo(ac[k]) * bflo(ax[k]); acc[2 * k + 1] += wv[tp][k >> 1][(2 * k + 1) & 3] * bfhi(ac[k]) * bfhi(ax[k]); }
                        }
                    }
                    u32x4 o;
#pragma unroll
                    for (int k = 0; k < 4; ++k) o[k] = pk2(bflo(ab[k]) * acc[2 * k] * bflo(az[k]), bfhi(ab[k]) * acc[2 * k + 1] * bfhi(az[k]));
                    *(u32x4*)(base + C_AB) = o;
                }
            }
            if (it == 1 || it == 2) {
                const size_t r0 = (size_t)(it - 1) * MHALF;
                for (int m = gw; m < MHALF; m += NGW) rms_row_to_bf16(out + (r0 + m) * D_MODEL, args.in[2] + D_MODEL, Hb + (r0 + m) * D_MODEL, lane);
            }
        }
        grid.sync();
        {
            pg8::StaticOrder S; S.init(MHALF, D_MODEL, G, bx);
            { pg8::Gemm g{PROJ + C_AB, WT_A(l), MHALF, D_MODEL, W_A, N_IN, W_A};
              pg8::EpiGate<0> E{PROJ + C_GA, PROJ + C_GA, MERGED};
              pg8::gemm_phase<pg8::EpiGate<0>>(lds, g, S, E); }
            { pg8::Gemm g{PROJ + C_Q, WT_B(l), MHALF, D_MODEL, W_B, N_IN, W_B};
              pg8::EpiGate<1> E{PROJ + C_GB, PROJ + C_GA, MERGED};
              pg8::gemm_phase<pg8::EpiGate<1>>(lds, g, S, E); }
            { pg8::Gemm g{PROJ + C_MQ, WT_M(l), MHALF, D_MODEL, W_M, N_IN, W_M};
              pg8::EpiGate<2> E{PROJ + C_GM, PROJ + C_GA, MERGED};
              pg8::gemm_phase<pg8::EpiGate<2>>(lds, g, S, E); }
        }
        grid.sync();
    }
}

extern "C" void kernel_launch(void* const* d_in, const int* in_sizes, int n_in, void* d_out, int out_size, void* d_ws, size_t ws_size, hipStream_t stream) {
    static int grid_blocks = 0;
    if (grid_blocks == 0) {
        if (n_in != 17 || in_sizes[0] != MTOK * D_MODEL || out_size != MTOK * D_MODEL || ws_size < WS_END) {
            fprintf(stderr, "kernel_launch: unexpected shapes (n_in %d, in0 %d, out %d, ws %zu < %zu); nothing launched\n", n_in, n_in > 0 ? in_sizes[0] : -1, out_size, ws_size, (size_t)WS_END);
            grid_blocks = -1; return; }
        int dev = 0, cus = 0, per_cu = 0;
        hipGetDevice(&dev);
        hipDeviceGetAttribute(&cus, hipDeviceAttributeMultiprocessorCount, dev);
        hipFuncSetAttribute((const void*)fwd_megakernel, hipFuncAttributeMaxDynamicSharedMemorySize, LDS_BYTES);
        hipOccupancyMaxActiveBlocksPerMultiprocessor(&per_cu, (const void*)fwd_megakernel, NTHREADS, LDS_BYTES);
        if (per_cu < 1) per_cu = 1;
        grid_blocks = cus * per_cu;
        (void)hipGetLastError();
    }
    if (grid_blocks < 0) return;
    Args a{};
    for (int i = 0; i < 17; ++i) a.in[i] = (const float*)d_in[i];
    a.out = (float*)d_out; a.ws = (unsigned char*)d_ws;
    void* kargs[] = {&a};
    hipError_t e = hipLaunchCooperativeKernel((const void*)fwd_megakernel, dim3(grid_blocks), dim3(NTHREADS), kargs, LDS_BYTES, stream);
    if (e != hipSuccess) fprintf(stderr, "cooperative launch failed: %s (grid %d)\n", hipGetErrorString(e), grid_blocks);
}
```

```cpp
#include <hip/hip_runtime.h>
#include <hip/hip_cooperative_groups.h>
#include <cstdio>
#include <cstdint>
namespace cg = cooperative_groups;

#define LAS __attribute__((address_space(3)))
typedef unsigned short bf16_t;
typedef short bf16x8 __attribute__((ext_vector_type(8)));
typedef short s16x4 __attribute__((ext_vector_type(4)));
typedef float f32x4 __attribute__((ext_vector_type(4)));
typedef float f32x16 __attribute__((ext_vector_type(16)));
typedef unsigned u32x4 __attribute__((ext_vector_type(4)));
typedef unsigned u32x2 __attribute__((ext_vector_type(2)));
typedef float f32x2_t __attribute__((ext_vector_type(2)));
typedef __bf16 bf16x2_t __attribute__((ext_vector_type(2)));

constexpr int D_MODEL = 2048, BATCH = 8, SEQ = 4096, DEPTH = 2, CHUNK = 64, MEM_LEN = 256, HEAD_DIM = 128;
constexpr int W_A = 512, W_B = 1024, W_M = 512, H_B = 8, H_M = 4, N_IN = 13312;
constexpr int MTOK = BATCH * SEQ;
constexpr int MHALF = MTOK / 2;
constexpr int MMEM = BATCH * MEM_LEN;
constexpr float EPS = 1e-6f;
constexpr float LOG2E = 1.4426950408889634f;
constexpr int PJW = 7168;
constexpr int C_AB = 0, C_AC = 512, C_AX = 1024, C_AZ = 1536, C_Q = 2048, C_K = 3072, C_V = 4096, C_BZ = 5120, C_MQ = 6144, C_MZ = 6656, C_GA = 7168, C_GB = 9216, C_GM = 11264;

__device__ __forceinline__ unsigned pk2(float lo, float hi) { f32x2_t v = {lo, hi}; bf16x2_t b = __builtin_convertvector(v, bf16x2_t); return __builtin_bit_cast(unsigned, b); }
__device__ __forceinline__ float bflo(unsigned w) { return __uint_as_float(w << 16); }
__device__ __forceinline__ float bfhi(unsigned w) { return __uint_as_float(w & 0xffff0000u); }
__device__ __forceinline__ float sigmoidf_(float v) { return __builtin_amdgcn_rcpf(1.0f + __builtin_amdgcn_exp2f(-v * LOG2E)); }
__device__ __forceinline__ float row16_sum(float v) {
    v += __uint_as_float(__builtin_amdgcn_update_dpp(0u, __float_as_uint(v), 0xB1, 0xF, 0xF, true));
    v += __uint_as_float(__builtin_amdgcn_update_dpp(0u, __float_as_uint(v), 0x4E, 0xF, 0xF, true));
    v += __uint_as_float(__builtin_amdgcn_update_dpp(0u, __float_as_uint(v), 0x124, 0xF, 0xF, true));
    v += __uint_as_float(__builtin_amdgcn_update_dpp(0u, __float_as_uint(v), 0x128, 0xF, 0xF, true));
    return v;
}
__device__ __forceinline__ float half_sum(float v) { auto rr = __builtin_amdgcn_permlane32_swap(__float_as_uint(v), __float_as_uint(v), false, false); return __uint_as_float(rr[0]) + __uint_as_float(rr[1]); }
__device__ __forceinline__ float half_max(float v) { auto rr = __builtin_amdgcn_permlane32_swap(__float_as_uint(v), __float_as_uint(v), false, false); return fmaxf(__uint_as_float(rr[0]), __uint_as_float(rr[1])); }
__device__ __forceinline__ float wave_sum(float v) {
#pragma unroll
    for (int o = 1; o < 64; o <<= 1) v += __shfl_xor(v, o);
    return v;
}

namespace pg8 {
constexpr int BM = 256, BK = 64, HALF = 128, HTB = HALF * BK * 2, STAGE_BYTES = 8 * HTB, NXCD = 8, WGM = 8;
__host__ __device__ __forceinline__ int lds_byte(int r, int c) { const int st = (r >> 4) * 2 + (c >> 5), rr = r & 15, cc = c & 31, ob = rr * 64 + cc * 2; return st * 1024 + (ob ^ (((ob >> 9) & 1) << 5)); }
__host__ __device__ __forceinline__ void stage_rc(int b, int& R, int& C) { const int st = b / 1024, sb = b % 1024, swz = sb ^ (((sb >> 9) & 1) << 5); R = (st >> 1) * 16 + swz / 64; C = (st & 1) * 32 + (swz % 64) / 2; }
__host__ __device__ __forceinline__ int perm32(int rho) { const int n = rho >> 4, i = rho & 15; return 8 * (i >> 2) + 4 * n + (i & 3); }

struct Unit { int pm, pn; };
__device__ __forceinline__ unsigned gt_off(int br, int pm, int pn, int wid, int lane) { return (unsigned)(((br * 64 + pm) * 8 + pn) * 65536 + wid * 8192 + lane * 8); }
__device__ __forceinline__ float ub(unsigned w, int k) { return (float)((w >> (8 * k)) & 0xffu); }
struct Gemm { const bf16_t* A; const bf16_t* Bt; int M, N, K, lda, ldb; };

struct StaticOrder {
    int nM, nN, nwg, G, c, wgm;
    __device__ void init(int M, int N, int G_, int c_, int wgm_ = WGM) { nM = M / BM; nN = N / BM; nwg = nM * nN; G = G_; c = c_; wgm = wgm_; }
    __device__ bool next(int i, Unit& u) const {
        const long L = (long)i * G + c; if (L >= nwg) return false;
        int wgid = (int)L; { const int q = nwg / NXCD, r = nwg % NXCD, xcd = wgid % NXCD, off = wgid / NXCD; wgid = (xcd < r ? xcd * (q + 1) : r * (q + 1) + (xcd - r) * q) + off; }
        const int nig = wgm * nN, gid = wgid / nig, fm = gid * wgm, gsz = (nM - fm) < wgm ? (nM - fm) : wgm;
        u.pm = fm + ((wgid % nig) % gsz); u.pn = (wgid % nig) / gsz; return true;
    }
};

struct EpiBf16 {
    static constexpr bool PERM = true;
    bf16_t* O; int ldc;
    __device__ __forceinline__ void operator()(const f32x4 (&acc)[2][2][4][2], const Unit& u, int wr, int wc, int fr, int fq) const {
        const int row0 = u.pm * BM + wr * 64 + fr, col0 = u.pn * BM + wc * 32 + 8 * fq;
#pragma unroll
        for (int ai = 0; ai < 2; ++ai)
#pragma unroll
            for (int m = 0; m < 4; ++m) { bf16_t* rowp = O + (size_t)(row0 + ai * HALF + m * 16) * ldc + col0;
#pragma unroll
                for (int bj = 0; bj < 2; ++bj) { const f32x4 v0 = acc[ai][bj][m][0], v1 = acc[ai][bj][m][1];
                    u32x4 w; w.x = pk2(v0[0], v0[1]); w.y = pk2(v0[2], v0[3]); w.z = pk2(v1[0], v1[1]); w.w = pk2(v1[2], v1[3]);
                    *(u32x4*)(rowp + bj * HALF) = w; } }
    }
};
struct EpiProj {
    static constexpr bool PERM = true;
    bf16_t* O; int ldc; const float* bgate; bf16_t* GT; const float* ssq;
    const float* gk; LAS float* xl;
    __device__ __forceinline__ void operator()(const f32x4 (&acc)[2][2][4][2], const Unit& u, int wr, int wc, int fr, int fq) const {
        const int colt = u.pn * BM;
        int mode = 0;
        if (colt >= C_GA) mode = 2; else if ((colt >= C_AZ && colt < C_Q) || (colt >= C_BZ && colt < C_MQ) || (colt >= C_MZ)) mode = 1;
        const bool knorm = (colt >= C_K && colt < C_V);
        const int row0 = u.pm * BM + wr * 64 + fr, col0 = colt + wc * 32 + 8 * fq;
        f32x4 bv[2][2];
#pragma unroll
        for (int bj = 0; bj < 2; ++bj)
#pragma unroll
            for (int n = 0; n < 2; ++n) bv[bj][n] = (mode == 2) ? *(const f32x4*)(bgate + (col0 - C_GA) + bj * HALF + 4 * n) : (f32x4){0.f, 0.f, 0.f, 0.f};
        float rk[2][4][2];
        f32x4 gkv[2];
        if (knorm) {
            gkv[0] = *(const f32x4*)(gk + wc * 32 + 8 * fq); gkv[1] = *(const f32x4*)(gk + wc * 32 + 8 * fq + 4);
#pragma unroll
            for (int ai = 0; ai < 2; ++ai)
#pragma unroll
                for (int m = 0; m < 4; ++m) { const float rstd = rsqrtf(ssq[row0 + ai * HALF + m * 16] * (1.0f / D_MODEL) + EPS);
#pragma unroll
                    for (int bj = 0; bj < 2; ++bj) { const f32x4 v0 = acc[ai][bj][m][0] * rstd, v1 = acc[ai][bj][m][1] * rstd;
                        float sq = (v0[0] * v0[0] + v0[1] * v0[1]) + (v0[2] * v0[2] + v0[3] * v0[3]) + (v1[0] * v1[0] + v1[1] * v1[1]) + (v1[2] * v1[2] + v1[3] * v1[3]);
                        sq += __shfl_xor(sq, 16); sq += __shfl_xor(sq, 32);
                        if (fq == 0) xl[((ai * HALF + wr * 64 + m * 16 + fr) * 2 + bj) * 4 + wc] = sq; } }
            asm volatile("s_waitcnt lgkmcnt(0)\n\ts_barrier" ::: "memory");
#pragma unroll
            for (int ai = 0; ai < 2; ++ai)
#pragma unroll
                for (int m = 0; m < 4; ++m)
#pragma unroll
                    for (int bj = 0; bj < 2; ++bj) { const f32x4 t = *(const LAS f32x4*)(xl + ((ai * HALF + wr * 64 + m * 16 + fr) * 2 + bj) * 4);
                        rk[ai][m][bj] = rsqrtf(((t[0] + t[1]) + (t[2] + t[3])) * (1.0f / HEAD_DIM) + EPS); }
        }
#pragma unroll
        for (int ai = 0; ai < 2; ++ai)
#pragma unroll
            for (int m = 0; m < 4; ++m) { bf16_t* rowp = O + ((size_t)(colt >> 7) * MHALF + (row0 + ai * HALF + m * 16)) * 128 + wc * 32 + 8 * fq;
                const float rstd = rsqrtf(ssq[row0 + ai * HALF + m * 16] * (1.0f / D_MODEL) + EPS);
#pragma unroll
                for (int bj = 0; bj < 2; ++bj) { f32x4 v0 = acc[ai][bj][m][0] * rstd + bv[bj][0], v1 = acc[ai][bj][m][1] * rstd + bv[bj][1];
                    if (mode != 0) {
                        const float nr = -LOG2E * rstd;
#pragma unroll
                        for (int e = 0; e < 4; ++e) {
                            const float s0 = __builtin_amdgcn_rcpf(1.0f + __builtin_amdgcn_exp2f(__builtin_fmaf(acc[ai][bj][m][0][e], nr, -LOG2E * bv[bj][0][e])));
                            const float s1 = __builtin_amdgcn_rcpf(1.0f + __builtin_amdgcn_exp2f(__builtin_fmaf(acc[ai][bj][m][1][e], nr, -LOG2E * bv[bj][1][e])));
                            v0[e] = (mode == 1) ? v0[e] * s0 : s0; v1[e] = (mode == 1) ? v1[e] * s1 : s1; }
                    }
                    if (knorm) { v0 = v0 * rk[ai][m][bj] * gkv[0]; v1 = v1 * rk[ai][m][bj] * gkv[1]; }
                    if (mode == 2) { u32x2 q; q.x = 0u; q.y = 0u;
#pragma unroll
                        for (int e = 0; e < 4; ++e) { q.x = __builtin_amdgcn_cvt_pk_u8_f32(fmaxf(__builtin_rintf(v0[e] * 255.0f), 1.0f), e, q.x); q.y = __builtin_amdgcn_cvt_pk_u8_f32(fmaxf(__builtin_rintf(v1[e] * 255.0f), 1.0f), e, q.y); }
                        __builtin_nontemporal_store(q, (u32x2*)((char*)GT + gt_off((colt - C_GA) >> 11, u.pm, ((colt - C_GA) & 2047) >> 8, wr * 4 + wc, fq * 16 + fr) + (unsigned)(((ai * 4 + m) * 2 + bj) * 512))); }
                    else { u32x4 w; w.x = pk2(v0[0], v0[1]); w.y = pk2(v0[2], v0[3]); w.z = pk2(v1[0], v1[1]); w.w = pk2(v1[2], v1[3]);
                        __builtin_nontemporal_store(w, (u32x4*)(rowp + (size_t)bj * MHALF * 128)); } } }
    }
};
struct NoHook { static constexpr bool ON = false; __device__ __forceinline__ void operator()(f32x4 (&)[2][2][4][2], const Unit&, int, int, int, int, int) const {} };
struct HookGate {
    static constexpr bool ON = true;
    const bf16_t* GT;
    __device__ __forceinline__ void operator()(f32x4 (&acc)[2][2][4][2], const Unit& u, int t, int wr, int wc, int fr, int fq) const {
        if (t != W_A / BK && t != (W_A + W_B) / BK) return;
        const int b1 = (t == W_A / BK) ? 0 : 1;
        unsigned o1 = gt_off(b1, u.pm, u.pn, wr * 4 + wc, fq * 16 + fr); asm volatile("" : "+v"(o1));
        const unsigned o2 = o1 + 64u * 8u * 65536u;
        u32x2 g1[2][4][2], g2[2][4][2];
#pragma unroll
        for (int ai = 0; ai < 2; ++ai)
#pragma unroll
            for (int m = 0; m < 4; ++m)
#pragma unroll
                for (int bj = 0; bj < 2; ++bj) { const unsigned off = (unsigned)(((ai * 4 + m) * 2 + bj) * 512);
                    g1[ai][m][bj] = *(const u32x2*)((const char*)GT + o1 + off); g2[ai][m][bj] = *(const u32x2*)((const char*)GT + o2 + off); }
#pragma unroll
        for (int ai = 0; ai < 2; ++ai)
#pragma unroll
            for (int m = 0; m < 4; ++m)
#pragma unroll
                for (int bj = 0; bj < 2; ++bj)
#pragma unroll
                    for (int n = 0; n < 2; ++n)
#pragma unroll
                        for (int e = 0; e < 4; ++e) acc[ai][bj][m][n][e] *= ub(g1[ai][m][bj][n], e) * __builtin_amdgcn_rcpf(ub(g2[ai][m][bj][n], e));
        asm volatile("" ::: "memory");
    }
};
struct EpiGateFinal {
    static constexpr bool PERM = true;
    const bf16_t* GT; bf16_t* MG;
    __device__ __forceinline__ void operator()(const f32x4 (&acc)[2][2][4][2], const Unit& u, int wr, int wc, int fr, int fq) const {
        const int row0 = u.pm * BM + wr * 64 + fr, col0 = u.pn * BM + wc * 32 + 8 * fq;
        const unsigned ob = (unsigned)(row0 * D_MODEL + col0) * 2u, og = gt_off(2, u.pm, u.pn, wr * 4 + wc, fq * 16 + fr);
        u32x2 gg[2][4][2];
#pragma unroll
        for (int ai = 0; ai < 2; ++ai)
#pragma unroll
            for (int m = 0; m < 4; ++m)
#pragma unroll
                for (int bj = 0; bj < 2; ++bj) gg[ai][m][bj] = *(const u32x2*)((const char*)GT + og + (unsigned)(((ai * 4 + m) * 2 + bj) * 512));
        constexpr float S = 1.0f / 255.0f;
#pragma unroll
        for (int ai = 0; ai < 2; ++ai)
#pragma unroll
            for (int m = 0; m < 4; ++m)
#pragma unroll
                for (int bj = 0; bj < 2; ++bj) { const u32x2 g = gg[ai][m][bj];
                    const f32x4 a0 = acc[ai][bj][m][0] * S, a1 = acc[ai][bj][m][1] * S;
                    u32x4 w; w.x = pk2(ub(g.x, 0) * a0[0], ub(g.x, 1) * a0[1]); w.y = pk2(ub(g.x, 2) * a0[2], ub(g.x, 3) * a0[3]);
                    w.z = pk2(ub(g.y, 0) * a1[0], ub(g.y, 1) * a1[1]); w.w = pk2(ub(g.y, 2) * a1[2], ub(g.y, 3) * a1[3]);
                    *(u32x4*)((char*)MG + ob + (unsigned)((ai * HALF + m * 16) * D_MODEL + bj * HALF) * 2u) = w; }
    }
};
struct EpiResid {
    static constexpr bool PERM = true;
    const float* base; float* out; bf16_t* hbuf; const float* gnext; float* ssq; int first;
    __device__ __forceinline__ void operator()(const f32x4 (&acc)[2][2][4][2], const Unit& u, int wr, int wc, int fr, int fq) const {
        const int row0 = u.pm * BM + wr * 64 + fr, col0 = u.pn * BM + wc * 32 + 8 * fq;
        const unsigned ob = (unsigned)(row0 * D_MODEL + col0) * 4u;
        const bool hx = (first != 0);
        f32x4 gv[2][2];
#pragma unroll
        for (int bj = 0; bj < 2; ++bj)
#pragma unroll
            for (int n = 0; n < 2; ++n) { gv[bj][n] = *(const f32x4*)(gnext + col0 + bj * HALF + 4 * n);
                if (!hx) { gv[bj][n][0] = 1.0f / gv[bj][n][0]; gv[bj][n][1] = 1.0f / gv[bj][n][1]; gv[bj][n][2] = 1.0f / gv[bj][n][2]; gv[bj][n][3] = 1.0f / gv[bj][n][3]; } }
#pragma unroll
        for (int ai = 0; ai < 2; ++ai) {
            f32x4 bb[4][2][2];
            if (hx) {
#pragma unroll
                for (int mm = 0; mm < 4; ++mm)
#pragma unroll
                    for (int bj = 0; bj < 2; ++bj)
#pragma unroll
                        for (int n = 0; n < 2; ++n) bb[mm][bj][n] = *(const f32x4*)((const char*)base + ob + (unsigned)((ai * HALF + mm * 16) * D_MODEL + bj * HALF + n * 4) * 4u);
            } else {
                u32x4 hw[4][2];
#pragma unroll
                for (int mm = 0; mm < 4; ++mm)
#pragma unroll
                    for (int bj = 0; bj < 2; ++bj) hw[mm][bj] = *(const u32x4*)((const char*)hbuf + (ob >> 1) + (unsigned)((ai * HALF + mm * 16) * D_MODEL + bj * HALF) * 2u);
#pragma unroll
                for (int mm = 0; mm < 4; ++mm)
#pragma unroll
                    for (int bj = 0; bj < 2; ++bj) { const u32x4 h = hw[mm][bj];
                        bb[mm][bj][0] = (f32x4){bflo(h.x) * gv[bj][0][0], bfhi(h.x) * gv[bj][0][1], bflo(h.y) * gv[bj][0][2], bfhi(h.y) * gv[bj][0][3]};
                        bb[mm][bj][1] = (f32x4){bflo(h.z) * gv[bj][1][0], bfhi(h.z) * gv[bj][1][1], bflo(h.w) * gv[bj][1][2], bfhi(h.w) * gv[bj][1][3]}; }
            }
#pragma unroll
            for (int mm = 0; mm < 4; ++mm) {
                float sq = 0.f;
#pragma unroll
                for (int bj = 0; bj < 2; ++bj) {
                    const f32x4 x0 = bb[mm][bj][0] + acc[ai][bj][mm][0], x1 = bb[mm][bj][1] + acc[ai][bj][mm][1];
                    const unsigned eo = (unsigned)((ai * HALF + mm * 16) * D_MODEL + bj * HALF);
                    if (hx) {
                        sq += (x0[0] * x0[0] + x0[1] * x0[1]) + (x0[2] * x0[2] + x0[3] * x0[3]) + (x1[0] * x1[0] + x1[1] * x1[1]) + (x1[2] * x1[2] + x1[3] * x1[3]);
                        u32x4 w; w.x = pk2(x0[0] * gv[bj][0][0], x0[1] * gv[bj][0][1]); w.y = pk2(x0[2] * gv[bj][0][2], x0[3] * gv[bj][0][3]);
                        w.z = pk2(x1[0] * gv[bj][1][0], x1[1] * gv[bj][1][1]); w.w = pk2(x1[2] * gv[bj][1][2], x1[3] * gv[bj][1][3]);
                        *(u32x4*)((char*)hbuf + (ob >> 1) + eo * 2u) = w;
                    } else {
                        *(f32x4*)((char*)out + ob + eo * 4u) = x0; *(f32x4*)((char*)out + ob + eo * 4u + 16u) = x1;
                    }
                }
                if (hx) { sq += __shfl_xor(sq, 16); sq += __shfl_xor(sq, 32);
                    if (fq == 0) atomicAdd(ssq + row0 + ai * HALF + mm * 16, sq); }
            }
            asm volatile("" ::: "memory"); }
    }
};

template <class Epi, class Hook = NoHook>
__device__ __forceinline__ void gemm_phase(LAS unsigned char* lds, const Gemm g, const StaticOrder& S, const Epi& E, const Hook& HK = Hook()) {
    int tid_ = threadIdx.x; asm volatile("" : "+v"(tid_));
    const int tid = tid_, wid = __builtin_amdgcn_readfirstlane(tid >> 6), lane = tid & 63, wr = wid >> 2, wc = wid & 3, fr = lane & 15, fq = lane >> 4;
    const int K = g.K, nt = K / BK;
    unsigned voffA[2], voffB[2];
#pragma unroll
    for (int i = 0; i < 2; ++i) { int R, C; stage_rc(tid * 16 + i * 8192, R, C); const int Rb = Epi::PERM ? ((R & ~31) + perm32(R & 31)) : R;
        voffA[i] = (unsigned)(R * g.lda + C) * 2u; voffB[i] = (unsigned)(Rb * g.ldb + C) * 2u; }
    const size_t kstep = (size_t)(BK * 2);
    const size_t hA = (size_t)HALF * g.lda * 2, hB = (size_t)HALF * g.ldb * 2;
    const size_t tA = 2 * hA, tB = 2 * hB;
    const unsigned ldsw = (unsigned)wid * 1024u;
    const int aoff = lds_byte(wr * 64 + fr, fq * 8), boff = lds_byte(wc * 32 + fr, fq * 8);
#define PG8_SA(b, h) (((b) * 2 + (h)) * HTB)
#define PG8_SB(b, h) ((4 + (b) * 2 + (h)) * HTB)
#define PG8_STAGE(bufoff, gbase, voff) do { _Pragma("unroll") for (int _i = 0; _i < 2; ++_i) \
        __builtin_amdgcn_global_load_lds((const unsigned*)((const char*)(gbase) + (voff)[_i]), (LAS unsigned*)(lds + (bufoff) + ldsw + _i * 8192), 16, 0, 0); } while (0)
#define PG8_LDA(dst, b, h) do { _Pragma("unroll") for (int m = 0; m < 4; ++m) _Pragma("unroll") for (int k = 0; k < 2; ++k) dst[m][k] = *(const LAS bf16x8*)(lds + PG8_SA(b, h) + aoff + m * 2048 + k * 1024); } while (0)
#define PG8_LDB(dst, b, h) do { _Pragma("unroll") for (int n = 0; n < 2; ++n) _Pragma("unroll") for (int k = 0; k < 2; ++k) dst[n][k] = *(const LAS bf16x8*)(lds + PG8_SB(b, h) + boff + n * 2048 + k * 1024); } while (0)
#define PG8_MMA(ai, bj, At, Bt) do { __builtin_amdgcn_s_setprio(0); _Pragma("unroll") for (int m = 0; m < 4; ++m) _Pragma("unroll") for (int n = 0; n < 2; ++n) _Pragma("unroll") for (int k = 0; k < 2; ++k) \
        acc[ai][bj][m][n] = __builtin_amdgcn_mfma_f32_16x16x32_bf16(Bt[n][k], At[m][k], acc[ai][bj][m][n], 0, 0, 0); __builtin_amdgcn_s_setprio(0); } while (0)
#define PG8_WAIT_V(n) asm volatile("s_waitcnt vmcnt(" #n ")" ::: "memory")
#define PG8_WAIT_L(n) asm volatile("s_waitcnt lgkmcnt(" #n ")" ::: "memory")
#define PG8_BAR __builtin_amdgcn_s_barrier()
#define PG8_SCHED __builtin_amdgcn_sched_barrier(0)
    Unit cur, nxt; int ui = 0;
    if (!S.next(0, cur)) return;
    f32x4 acc[2][2][4][2];
#pragma unroll
    for (int a = 0; a < 2; ++a)
#pragma unroll
        for (int b = 0; b < 2; ++b)
#pragma unroll
            for (int m = 0; m < 4; ++m)
#pragma unroll
                for (int n = 0; n < 2; ++n) acc[a][b][m][n] = (f32x4){0.f, 0.f, 0.f, 0.f};
    bf16x8 At[4][2], B0[2][2], B1[2][2];
    const char* cA = (const char*)g.A + (size_t)cur.pm * tA; const char* cB = (const char*)g.Bt + (size_t)cur.pn * tB;
    PG8_STAGE(PG8_SB(0, 0), cB, voffB); PG8_STAGE(PG8_SB(0, 1), cB + hB, voffB); PG8_STAGE(PG8_SA(0, 0), cA, voffA); PG8_STAGE(PG8_SA(0, 1), cA + hA, voffA);
    if (wr == 1) PG8_BAR;
    PG8_WAIT_V(2); PG8_BAR;
    PG8_STAGE(PG8_SB(1, 0), cB + kstep, voffB); PG8_STAGE(PG8_SA(1, 0), cA + kstep, voffA); PG8_STAGE(PG8_SB(1, 1), cB + hB + kstep, voffB);
    PG8_WAIT_V(6); PG8_BAR;
    for (;;) {
        const bool has_next = S.next(ui + 1, nxt);
        const char* nA = has_next ? (const char*)g.A + (size_t)nxt.pm * tA : cA; const char* nB = has_next ? (const char*)g.Bt + (size_t)nxt.pn * tB : cB;
        for (int t = 0; t < nt; t += 2) {
            const bool last = (t == nt - 2);
            const char* a1 = cA + (size_t)(t + 1) * kstep;
            const char* a2 = last ? nA : cA + (size_t)(t + 2) * kstep; const char* b2 = last ? nB : cB + (size_t)(t + 2) * kstep;
            const char* a3 = a2 + kstep; const char* b3 = b2 + kstep;
            if constexpr (Hook::ON) HK(acc, cur, t, wr, wc, fr, fq);
            PG8_LDB(B0, 0, 0); PG8_LDB(B1, 0, 1); PG8_SCHED; PG8_LDA(At, 0, 0); PG8_STAGE(PG8_SA(1, 1), a1 + hA, voffA);
            PG8_WAIT_V(8); PG8_WAIT_L(0); PG8_BAR; PG8_MMA(0, 0, At, B0); PG8_MMA(0, 1, At, B1); PG8_BAR; PG8_SCHED;
            PG8_LDA(At, 0, 1); PG8_STAGE(PG8_SB(0, 0), b2, voffB); PG8_STAGE(PG8_SB(0, 1), b2 + hB, voffB); PG8_STAGE(PG8_SA(0, 0), a2, voffA);
            PG8_WAIT_V(8); PG8_WAIT_L(0); PG8_BAR; PG8_MMA(1, 0, At, B0); PG8_MMA(1, 1, At, B1); PG8_BAR; PG8_SCHED;
            PG8_LDB(B0, 1, 0); PG8_LDB(B1, 1, 1); PG8_SCHED; PG8_LDA(At, 1, 0); PG8_STAGE(PG8_SA(0, 1), a2 + hA, voffA);
            PG8_WAIT_V(8); PG8_WAIT_L(0); PG8_BAR; PG8_MMA(0, 0, At, B0); PG8_MMA(0, 1, At, B1); PG8_BAR; PG8_SCHED;
            PG8_LDA(At, 1, 1); PG8_STAGE(PG8_SB(1, 0), b3, voffB); PG8_STAGE(PG8_SB(1, 1), b3 + hB, voffB); PG8_STAGE(PG8_SA(1, 0), a3, voffA);
            PG8_WAIT_V(8); PG8_WAIT_L(0); PG8_BAR; PG8_MMA(1, 0, At, B0); PG8_MMA(1, 1, At, B1); PG8_BAR; PG8_SCHED;
        }
        if (wr == 0) PG8_BAR;
        E(acc, cur, wr, wc, fr, fq);
        if (!has_next) break;
#pragma unroll
        for (int a = 0; a < 2; ++a)
#pragma unroll
            for (int b = 0; b < 2; ++b)
#pragma unroll
                for (int m = 0; m < 4; ++m)
#pragma unroll
                    for (int n = 0; n < 2; ++n) acc[a][b][m][n] = (f32x4){0.f, 0.f, 0.f, 0.f};
        cur = nxt; cA = nA; cB = nB; ++ui;
        if (wr == 1) PG8_BAR;
    }
    PG8_WAIT_V(0);
    PG8_BAR;
#undef PG8_SA
#undef PG8_SB
#undef PG8_STAGE
#undef PG8_LDA
#undef PG8_LDB
#undef PG8_MMA
#undef PG8_WAIT_V
#undef PG8_WAIT_L
#undef PG8_BAR
#undef PG8_SCHED
}
}

namespace at {
constexpr int KSTR = 272, VSTR = 320;
constexpr int AT_K = 0, AT_V = 2 * 64 * KSTR, AT_TAB = AT_V + 2 * 64 * VSTR, AT_END = AT_TAB + 640 * 4;
__device__ __forceinline__ s16x4 vtr(const LAS unsigned char* p) { return __builtin_bit_cast(s16x4, __builtin_amdgcn_ds_read_tr16_b64_v4i16((LAS s16x4*)p)); }

template <bool CH, bool KN>
__device__ __forceinline__ void attn_unit(LAS unsigned char* lds, const bf16_t* QO, const bf16_t* SZ, int ldq, bf16_t* OB, int ldo, const bf16_t* Kb, const bf16_t* Vb, int ldk,
                                          int q_row0, int k_row0, int jstart, int ntiles, const float* gq, const float* gk, const float* rel) {
    int tid_ = threadIdx.x; asm volatile("" : "+v"(tid_));
    const int tid = tid_, lane = tid & 63, w = __builtin_amdgcn_readfirstlane(tid >> 6), r32 = lane & 31, hh = lane >> 5;
    LAS float* tab = (LAS float*)(lds + AT_TAB);
    if (CH) { for (int e = tid; e < 640; e += 512) { int idx = e - 63; idx = idx < -256 ? -256 : (idx > 256 ? 256 : idx); tab[e] = rel[(idx + 256) * 8] * LOG2E; } }
    const int srow = tid >> 4, sc = tid & 15;
    const f32x4 gk0 = *(const f32x4*)(gk + 8 * sc), gk1 = *(const f32x4*)(gk + 8 * sc + 4);
    u32x4 kr[2], vr[2];
#define AT_GLOAD(j) do { const size_t ro_ = (size_t)(k_row0 + (j) * 64 + srow) * ldk + 8 * sc; \
        kr[0] = *(const u32x4*)(Kb + ro_); kr[1] = *(const u32x4*)(Kb + ro_ + (size_t)32 * ldk); vr[0] = *(const u32x4*)(Vb + ro_); vr[1] = *(const u32x4*)(Vb + ro_ + (size_t)32 * ldk); } while (0)
#define AT_SSTORE(buf) do { _Pragma("unroll") for (int i_ = 0; i_ < 2; ++i_) { const u32x4 kq = kr[i_]; u32x4 kn = kq; \
        if (KN) { float s_ = bflo(kq.x) * bflo(kq.x) + bfhi(kq.x) * bfhi(kq.x) + bflo(kq.y) * bflo(kq.y) + bfhi(kq.y) * bfhi(kq.y) + bflo(kq.z) * bflo(kq.z) + bfhi(kq.z) * bfhi(kq.z) + bflo(kq.w) * bflo(kq.w) + bfhi(kq.w) * bfhi(kq.w); \
        s_ = row16_sum(s_); \
        const float rk_ = rsqrtf(s_ * (1.0f / 128.0f) + EPS); \
        kn.x = pk2(bflo(kq.x) * rk_ * gk0[0], bfhi(kq.x) * rk_ * gk0[1]); kn.y = pk2(bflo(kq.y) * rk_ * gk0[2], bfhi(kq.y) * rk_ * gk0[3]); \
        kn.z = pk2(bflo(kq.z) * rk_ * gk1[0], bfhi(kq.z) * rk_ * gk1[1]); kn.w = pk2(bflo(kq.w) * rk_ * gk1[2], bfhi(kq.w) * rk_ * gk1[3]); } \
        *(LAS u32x4*)(lds + AT_K + (buf) * (64 * KSTR) + (srow + 32 * i_) * KSTR + 16 * sc) = kn; \
        *(LAS u32x4*)(lds + AT_V + (buf) * (64 * VSTR) + (srow + 32 * i_) * VSTR + 16 * sc) = vr[i_]; } } while (0)

    AT_GLOAD(jstart);
    const int qrow = q_row0 + 32 * w + r32;
    bf16x8 qf[8];
    {
        const bf16_t* qp = QO + (size_t)qrow * ldq + 8 * hh;
        u32x4 qraw[8];
#pragma unroll
        for (int ds = 0; ds < 8; ++ds) qraw[ds] = *(const u32x4*)(qp + 16 * ds);
        float ss = 0.f;
#pragma unroll
        for (int ds = 0; ds < 8; ++ds)
#pragma unroll
            for (int k = 0; k < 4; ++k) { const float a = bflo(qraw[ds][k]), b = bfhi(qraw[ds][k]); ss += a * a + b * b; }
        ss = half_sum(ss);
        const float rs = rsqrtf(ss * (1.0f / 128.0f) + EPS) * (0.08838834764831845f * LOG2E);
#pragma unroll
        for (int ds = 0; ds < 8; ++ds) {
            const f32x4 g0 = *(const f32x4*)(gq + 16 * ds + 8 * hh), g1 = *(const f32x4*)(gq + 16 * ds + 8 * hh + 4);
            u32x4 o;
            o.x = pk2(bflo(qraw[ds].x) * rs * g0[0], bfhi(qraw[ds].x) * rs * g0[1]); o.y = pk2(bflo(qraw[ds].y) * rs * g0[2], bfhi(qraw[ds].y) * rs * g0[3]);
            o.z = pk2(bflo(qraw[ds].z) * rs * g1[0], bfhi(qraw[ds].z) * rs * g1[1]); o.w = pk2(bflo(qraw[ds].w) * rs * g1[2], bfhi(qraw[ds].w) * rs * g1[3]);
            qf[ds] = __builtin_bit_cast(bf16x8, o);
        }
    }
    float mrun = -1e30f, lsum = 0.f;
    f32x16 o[4];
#pragma unroll
    for (int db = 0; db < 4; ++db)
#pragma unroll
        for (int i = 0; i < 16; ++i) o[db][i] = 0.f;
    AT_SSTORE(0);
    if (jstart + 1 < ntiles) AT_GLOAD(jstart + 1);
    __syncthreads();
#pragma unroll 1
    for (int j = jstart; j < ntiles; ++j) {
        const int buf = (j - jstart) & 1;
        const int jj = j - (w >> 1);
        const bool active = !CH || (jj >= 0 && jj <= 8);
        bf16x8 pf[2][2];
        if (active) {
            const LAS unsigned char* Kt = lds + AT_K + buf * (64 * KSTR) + r32 * KSTR + 16 * hh;
            f32x16 p0, p1;
            {
                bf16x8 kf[16];
#pragma unroll
                for (int ds = 0; ds < 8; ++ds) { kf[2 * ds] = *(const LAS bf16x8*)(Kt + 32 * ds); kf[2 * ds + 1] = *(const LAS bf16x8*)(Kt + 32 * KSTR + 32 * ds); }
                __builtin_amdgcn_sched_barrier(0);
                if (CH && jj <= 3) {
                    const float init = tab[638];
#pragma unroll
                    for (int i = 0; i < 16; ++i) { p0[i] = init; p1[i] = init; }
                    p0 = __builtin_amdgcn_mfma_f32_32x32x16_bf16(kf[0], qf[0], p0, 0, 0, 0);
                    p1 = __builtin_amdgcn_mfma_f32_32x32x16_bf16(kf[1], qf[0], p1, 0, 0, 0);
                } else {
                    const f32x16 zero16 = {0.f, 0.f, 0.f, 0.f, 0.f, 0.f, 0.f, 0.f, 0.f, 0.f, 0.f, 0.f, 0.f, 0.f, 0.f, 0.f};
                    p0 = __builtin_amdgcn_mfma_f32_32x32x16_bf16(kf[0], qf[0], zero16, 0, 0, 0);
                    p1 = __builtin_amdgcn_mfma_f32_32x32x16_bf16(kf[1], qf[0], zero16, 0, 0, 0);
                }
#pragma unroll
                for (int ds = 1; ds < 8; ++ds) {
                    p0 = __builtin_amdgcn_mfma_f32_32x32x16_bf16(kf[2 * ds], qf[ds], p0, 0, 0, 0);
                    p1 = __builtin_amdgcn_mfma_f32_32x32x16_bf16(kf[2 * ds + 1], qf[ds], p1, 0, 0, 0);
                }
            }
            if (CH && jj >= 4) {
                const LAS float* tb = tab + ((8 - jj) * 64 + 32 * (w & 1) + r32 - 4 * hh);
#pragma unroll
                for (int i = 0; i < 16; ++i) { p0[i] += tb[63 - (i & 3) - 8 * (i >> 2)]; p1[i] += tb[31 - (i & 3) - 8 * (i >> 2)]; }
            }
            float rm = __builtin_fmaxf(__builtin_fmaxf(p0[0], p1[0]), p0[1]);
#pragma unroll
            for (int i = 1; i < 15; ++i) rm = __builtin_fmaxf(__builtin_fmaxf(rm, p1[i]), p0[i + 1]);
            rm = half_max(__builtin_fmaxf(rm, p1[15]));
            const bool need = rm > mrun + 8.0f;
            if (__any(need)) {
                const float mn = need ? rm : mrun;
                const float alpha = __builtin_amdgcn_exp2f(mrun - mn);
                mrun = mn; lsum *= alpha;
#pragma unroll
                for (int db = 0; db < 4; ++db)
#pragma unroll
                    for (int i = 0; i < 16; ++i) o[db][i] *= alpha;
            }
            float ps = 0.f;
#pragma unroll
            for (int i = 0; i < 16; ++i) { p0[i] = __builtin_amdgcn_exp2f(p0[i] - mrun); p1[i] = __builtin_amdgcn_exp2f(p1[i] - mrun); ps += p0[i] + p1[i]; }
            lsum += ps;
#pragma unroll
            for (int s = 0; s < 2; ++s) {
                u32x4 a, b;
                a.x = pk2(p0[8 * s + 0], p0[8 * s + 1]); a.y = pk2(p0[8 * s + 2], p0[8 * s + 3]); a.z = pk2(p0[8 * s + 4], p0[8 * s + 5]); a.w = pk2(p0[8 * s + 6], p0[8 * s + 7]);
                b.x = pk2(p1[8 * s + 0], p1[8 * s + 1]); b.y = pk2(p1[8 * s + 2], p1[8 * s + 3]); b.z = pk2(p1[8 * s + 4], p1[8 * s + 5]); b.w = pk2(p1[8 * s + 6], p1[8 * s + 7]);
                pf[0][s] = __builtin_bit_cast(bf16x8, a); pf[1][s] = __builtin_bit_cast(bf16x8, b);
            }
        }
        if (j + 1 < ntiles) { AT_SSTORE(buf ^ 1); if (j + 2 < ntiles) AT_GLOAD(j + 2); }
        if (active) {
            const LAS unsigned char* Vt = lds + AT_V + buf * (64 * VSTR) + (4 * hh + ((lane & 15) >> 2)) * VSTR + (16 * ((lane >> 4) & 1) + 4 * (lane & 3)) * 2;
            s16x4 va[2][4][2];
#define AT_VLOAD(slot, g) do { _Pragma("unroll") for (int db_ = 0; db_ < 4; ++db_) { va[slot][db_][0] = vtr(Vt + (((g) >> 1) * 32 + 16 * ((g) & 1)) * VSTR + 64 * db_); va[slot][db_][1] = vtr(Vt + (((g) >> 1) * 32 + 16 * ((g) & 1) + 8) * VSTR + 64 * db_); } } while (0)
            AT_VLOAD(0, 0);
#pragma unroll
            for (int g = 0; g < 4; ++g) {
                if (g < 3) AT_VLOAD((g + 1) & 1, g + 1);
                __builtin_amdgcn_sched_barrier(0);
#pragma unroll
                for (int db = 0; db < 4; ++db) {
                    const bf16x8 vf = __builtin_shufflevector(va[g & 1][db][0], va[g & 1][db][1], 0, 1, 2, 3, 4, 5, 6, 7);
                    o[db] = __builtin_amdgcn_mfma_f32_32x32x16_bf16(vf, pf[g >> 1][g & 1], o[db], 0, 0, 0);
                }
                __builtin_amdgcn_sched_barrier(0);
            }
#undef AT_VLOAD
        }
        __syncthreads();
    }
#undef AT_GLOAD
#undef AT_SSTORE
    const float l = half_sum(lsum);
    const float inv = 1.0f / l;
    bf16_t* op = OB + (size_t)qrow * ldo + 4 * hh; const bf16_t* zp = SZ + (size_t)qrow * ldq + 4 * hh;
#pragma unroll
    for (int db = 0; db < 4; ++db)
#pragma unroll
        for (int g = 0; g < 4; ++g) {
            const int d = 32 * db + 8 * g;
            const u32x2 z = *(const u32x2*)(zp + d);
            u32x2 r;
            r.x = pk2(o[db][4 * g + 0] * inv * bflo(z.x), o[db][4 * g + 1] * inv * bfhi(z.x));
            r.y = pk2(o[db][4 * g + 2] * inv * bflo(z.y), o[db][4 * g + 3] * inv * bfhi(z.y));
            *(u32x2*)(op + d) = r;
        }
}
}


#define XB_TMO      128
#define XB_XCNT(j)  (256  + 64 * (j))
#define XB_XSUB(j)  (1280 + 64 * (j))
#define XB_XGEN(j)  (2304 + 64 * (j))
#define XB_TOP      3328
#define XB_TOPGEN   3392
#define XCD_BAR_WORDS 3456
#define XB_SPIN_CAP (1u << 18)
__device__ __forceinline__ unsigned xb_ld(unsigned* p)              { return __hip_atomic_load(p, __ATOMIC_RELAXED, __HIP_MEMORY_SCOPE_AGENT); }
__device__ __forceinline__ unsigned xb_add(unsigned* p, unsigned v) { return __hip_atomic_fetch_add(p, v, __ATOMIC_RELAXED, __HIP_MEMORY_SCOPE_AGENT); }
__device__ __forceinline__ unsigned xb_xcc_id() { return (unsigned)__builtin_amdgcn_s_getreg((3 << 11) | 20) & 0xFu; }
#define XB_SPIN(cond, bar) do { unsigned _sp = 0; while (cond) { __builtin_amdgcn_s_sleep(1); \
    if ((++_sp & 255u) == 0u) { if (xb_ld(&(bar)[XB_TMO])) break; if (_sp > XB_SPIN_CAP) { atomicAdd(&(bar)[XB_TMO], 1u); break; } } } } while (0)
struct XcdBarrier { unsigned* bar; unsigned x; volatile LAS unsigned* st; };
__device__ __forceinline__ XcdBarrier xcd_barrier_post(unsigned* bar, volatile LAS unsigned* st) {
    XcdBarrier b; b.bar = bar; b.x = xb_xcc_id(); b.st = st;
    if (threadIdx.x == 0) (void)xb_add(&bar[XB_XCNT(b.x)], 1u);
    return b;
}
__device__ __forceinline__ void xcd_barrier_complete(unsigned* bar, unsigned x, unsigned& nloc, unsigned& nx) {
    const unsigned G = gridDim.x * gridDim.y * gridDim.z;
    unsigned sum, cnt, mine, sp = 0u;
    for (;;) {
        sum = 0u; cnt = 0u; mine = 0u;
#pragma unroll
        for (unsigned j = 0; j < 16; ++j) { const unsigned c = xb_ld(&bar[XB_XCNT(j)]); sum += c; cnt += (c > 0u) ? 1u : 0u; mine = (j == x) ? c : mine; }
        if (sum == G) break;
        __builtin_amdgcn_s_sleep(1);
        if ((++sp & 255u) == 0u) { if (xb_ld(&bar[XB_TMO])) break; if (sp > XB_SPIN_CAP) { atomicAdd(&bar[XB_TMO], 1u); break; } }
    }
    nloc = mine > 0u ? mine : 1u; nx = cnt > 0u ? cnt : 1u;
}
__device__ __forceinline__ void xcd_barrier(const XcdBarrier& b) {
    asm volatile("s_waitcnt vmcnt(0)" ::: "memory");
    __syncthreads();
    if (threadIdx.x == 0) {
        unsigned* bar = b.bar;
        __builtin_amdgcn_s_waitcnt(0);
        unsigned nloc = b.st[0], nx = b.st[1];
        if (nloc == 0u) { xcd_barrier_complete(bar, b.x, nloc, nx); b.st[0] = nloc; b.st[1] = nx; }
        const unsigned old = xb_add(&bar[XB_XSUB(b.x)], 1u);
        const unsigned gen = old / nloc;
        if (old + 1u == (gen + 1u) * nloc) {
            __builtin_amdgcn_fence(__ATOMIC_RELEASE, "agent");
            asm volatile("s_waitcnt vmcnt(0)" ::: "memory");
            const unsigned og = xb_add(&bar[XB_TOP], 1u);
            const unsigned tg = og / nx;
            if (og + 1u == (tg + 1u) * nx) xb_add(&bar[XB_TOPGEN], 1u);
            else XB_SPIN(xb_ld(&bar[XB_TOPGEN]) == tg, bar);
            __builtin_amdgcn_fence(__ATOMIC_ACQUIRE, "agent");
            xb_add(&bar[XB_XGEN(b.x)], 1u);
            asm volatile("s_waitcnt vmcnt(0)" ::: "memory");
        } else {
            XB_SPIN(xb_ld(&bar[XB_XGEN(b.x)]) == gen, bar);
            __builtin_amdgcn_fence(__ATOMIC_ACQUIRE, "agent");
            asm volatile("s_waitcnt vmcnt(0)" ::: "memory");
        }
    }
    __syncthreads();
}

#ifndef WGM_P1
#define WGM_P1 4
#endif
#ifndef WGM_P4
#define WGM_P4 4
#endif
#ifndef WGM_C
#define WGM_C 4
#endif
constexpr int NWAVES = 8, NTHREADS = 512;
constexpr int LDS_BYTES = 147456;
constexpr size_t MiB = 1u << 20;
constexpr size_t SZ_WIN = (size_t)N_IN * D_MODEL * 2, SZ_WA = (size_t)D_MODEL * W_A * 2, SZ_WB = (size_t)D_MODEL * W_B * 2, SZ_WM = (size_t)D_MODEL * W_M * 2,
                 SZ_WO = (size_t)D_MODEL * D_MODEL * 2, SZ_WMEM = (size_t)(2 * W_M) * D_MODEL * 2;
constexpr size_t SZ_WL = SZ_WIN + SZ_WA + SZ_WB + SZ_WM + SZ_WO + SZ_WMEM;
constexpr size_t WS_SS = 131072;
constexpr size_t WS_CTL = 0, CTL_ZERO_BYTES = 16384;
constexpr size_t WS_W = 1 * MiB;
constexpr int LDS_MISC = 131072, LDS_XL = 131072 + 256;
constexpr size_t WS_MEMN = WS_W + DEPTH * SZ_WL;
constexpr size_t WS_MKV = WS_MEMN + (size_t)DEPTH * MMEM * D_MODEL * 2;
constexpr size_t WS_H = WS_MKV + (size_t)DEPTH * MMEM * (2 * W_M) * 2;
constexpr size_t WS_MERGED = WS_H + (size_t)MTOK * D_MODEL * 2;
constexpr size_t WS_PROJ = WS_MERGED + (size_t)MHALF * D_MODEL * 2;
constexpr size_t WS_GT = WS_PROJ + (size_t)MHALF * PJW * 2;
constexpr size_t WS_Y = WS_GT + (size_t)3 * 64 * 8 * 65536;
constexpr size_t WS_END = WS_Y + (size_t)MHALF * D_MODEL * 2;
constexpr int Y_A = 0, Y_B = 512, Y_M = 1536;
static_assert(WS_END <= (size_t)1024 * MiB, "workspace map must fit 1 GiB");

__device__ __forceinline__ void p0_transpose_item(const float* W, int K, int N, bf16_t* WT, int ldwt, LAS float* scr, int item, int lane) {
    const int nblk = N / 32, kb = item / nblk, nb = item % nblk, k0 = 64 * kb, n0 = 32 * nb;
#pragma unroll 8
    for (int i = 0; i < 32; ++i) { const int kk = 2 * i + (lane >> 5); scr[kk * 33 + (lane & 31)] = W[(size_t)(k0 + kk) * N + n0 + (lane & 31)]; }
    asm volatile("s_waitcnt lgkmcnt(0)" ::: "memory");
    const int c = lane & 7;
#pragma unroll
    for (int j = 0; j < 4; ++j) { const int n = (lane >> 3) + 8 * j; const LAS float* s = scr + (8 * c) * 33 + n;
        u32x4 o; o.x = pk2(s[0 * 33], s[1 * 33]); o.y = pk2(s[2 * 33], s[3 * 33]); o.z = pk2(s[4 * 33], s[5 * 33]); o.w = pk2(s[6 * 33], s[7 * 33]);
        *(u32x4*)(WT + (size_t)(n0 + n) * ldwt + k0 + 8 * c) = o; }
    asm volatile("s_waitcnt lgkmcnt(0)" ::: "memory");
}
__device__ __forceinline__ void rms_row_to_bf16(const float* xrow, const float* g, bf16_t* orow, int lane) {
    const f32x4* xr = (const f32x4*)xrow + lane; const f32x4* gr = (const f32x4*)g + lane;
    f32x4 v[8]; float s = 0.f;
#pragma unroll
    for (int j = 0; j < 8; ++j) { v[j] = xr[64 * j]; s += (v[j].x * v[j].x + v[j].y * v[j].y) + (v[j].z * v[j].z + v[j].w * v[j].w); }
    const float rstd = rsqrtf(wave_sum(s) * (1.f / D_MODEL) + EPS);
    u32x2* o8 = (u32x2*)orow + lane;
#pragma unroll
    for (int j = 0; j < 8; ++j) { const f32x4 gg = gr[64 * j]; u32x2 r; r.x = pk2(v[j].x * rstd * gg.x, v[j].y * rstd * gg.y); r.y = pk2(v[j].z * rstd * gg.z, v[j].w * rstd * gg.w); o8[64 * j] = r; }
}

__device__ __forceinline__ void scale_row_to_bf16(const float* xrow, const float* g, bf16_t* orow, float* ss_out, int lane) {
    const f32x4* xr = (const f32x4*)xrow + lane; const f32x4* gr = (const f32x4*)g + lane;
    f32x4 v[8]; float s = 0.f;
#pragma unroll
    for (int j = 0; j < 8; ++j) { v[j] = xr[64 * j]; s += (v[j].x * v[j].x + v[j].y * v[j].y) + (v[j].z * v[j].z + v[j].w * v[j].w); }
    s = wave_sum(s);
    if (lane == 0) *ss_out = s;
    u32x2* o8 = (u32x2*)orow + lane;
#pragma unroll
    for (int j = 0; j < 8; ++j) { const f32x4 gg = gr[64 * j]; u32x2 r; r.x = pk2(v[j].x * gg.x, v[j].y * gg.y); r.y = pk2(v[j].z * gg.z, v[j].w * gg.w); o8[64 * j] = r; }
}
struct Args { const float* in[17]; float* out; unsigned char* ws; };


#ifdef PROBE_SEL
#define TS_BEGIN(cat) do { if (PROBE_SEL == (cat)) tstart = __builtin_amdgcn_s_memrealtime(); } while (0)
#define TS_END(cat) do { if (PROBE_SEL == (cat)) tacc += __builtin_amdgcn_s_memrealtime() - tstart; } while (0)
#else
#define TS_BEGIN(cat) do {} while (0)
#define TS_END(cat) do {} while (0)
#endif
#ifndef PROBE_DUP
#define PROBE_DUP 0
#endif
constexpr int REP_P1 = (PROBE_DUP == 1) ? 2 : 1, REP_B = (PROBE_DUP == 2) ? 2 : 1, REP_C = (PROBE_DUP == 3) ? 2 : 1, REP_SYNC = (PROBE_DUP == 4) ? 2 : 1, REP_P0 = (PROBE_DUP == 5) ? 2 : 1, REP_P4 = (PROBE_DUP == 6) ? 2 : 1, REP_CA = (PROBE_DUP == 7) ? 2 : 1, REP_MA = (PROBE_DUP == 8) ? 2 : 1, REP_CV = (PROBE_DUP == 9) ? 2 : 1, REP_MA0 = (PROBE_DUP == 10) ? 2 : 1, REP_CA0 = (PROBE_DUP == 11) ? 2 : 1;
#define GSYNC() do { TS_BEGIN(5); for (int rs_ = 0; rs_ < REP_SYNC; ++rs_) xcd_barrier(xbar); TS_END(5); } while (0)
__global__ void __launch_bounds__(NTHREADS, 2) fwd_megakernel(Args args) {
#ifdef PROBE_SEL
    unsigned long long tstart = 0, tacc = 0;
#endif
    extern __shared__ __attribute__((aligned(16))) unsigned char lds_raw[];
    LAS unsigned char* lds = (LAS unsigned char*)lds_raw;
    cg::grid_group grid = cg::this_grid();
    const int tid = threadIdx.x, lane = tid & 63, wave = __builtin_amdgcn_readfirstlane(tid >> 6);
    const int G = gridDim.x, bx = blockIdx.x;
    const int gw = bx * NWAVES + wave, NGW = G * NWAVES;
    const int vcu = (G % 8 == 0) ? (bx % 8) * (G / 8) + bx / 8 : bx;
    unsigned char* ws = args.ws;
    if (tid < 2) ((volatile LAS unsigned*)(lds + LDS_MISC))[tid] = 0u;
    __syncthreads();
    const XcdBarrier xbar = xcd_barrier_post((unsigned*)(ws + WS_CTL), (volatile LAS unsigned*)(lds + LDS_MISC));
    float* out = args.out;
    bf16_t* Hb = (bf16_t*)(ws + WS_H); bf16_t* MERGED = (bf16_t*)(ws + WS_MERGED); bf16_t* PROJ = (bf16_t*)(ws + WS_PROJ); bf16_t* YB = (bf16_t*)(ws + WS_Y); bf16_t* GT = (bf16_t*)(ws + WS_GT); float* SSQ = (float*)(ws + WS_SS);
    bf16_t* MEMN = (bf16_t*)(ws + WS_MEMN); bf16_t* MKV = (bf16_t*)(ws + WS_MKV);
#define WT_IN(l)  ((bf16_t*)(ws + WS_W + (size_t)(l) * SZ_WL))
#define WT_A(l)   ((bf16_t*)(ws + WS_W + (size_t)(l) * SZ_WL + SZ_WIN))
#define WT_B(l)   ((bf16_t*)(ws + WS_W + (size_t)(l) * SZ_WL + SZ_WIN + SZ_WA))
#define WT_M(l)   ((bf16_t*)(ws + WS_W + (size_t)(l) * SZ_WL + SZ_WIN + SZ_WA + SZ_WB))
#define WT_O(l)   ((bf16_t*)(ws + WS_W + (size_t)(l) * SZ_WL + SZ_WIN + SZ_WA + SZ_WB + SZ_WM))
#define WT_MEM(l) ((bf16_t*)(ws + WS_W + (size_t)(l) * SZ_WL + SZ_WIN + SZ_WA + SZ_WB + SZ_WM + SZ_WO))

#define PJB(col) (PROJ + (size_t)((col) >> 7) * MHALF * 128)
    TS_BEGIN(0);
    for (int rep = 0; rep < REP_P0; ++rep) {
        LAS float* scr = (LAS float*)(lds + wave * 16384);
        constexpr int I_IN = (D_MODEL / 64) * (N_IN / 32), I_A = (W_A / 64) * (D_MODEL / 32), I_B = (W_B / 64) * (D_MODEL / 32), I_M = (W_M / 64) * (D_MODEL / 32),
                      I_O = (D_MODEL / 64) * (D_MODEL / 32), I_MEM = (D_MODEL / 64) * (2 * W_M / 32);
        constexpr int I_L = I_IN + I_A + I_B + I_M + I_O + I_MEM;
        for (int it = gw; it < DEPTH * I_L; it += NGW) {
            const int l = it / I_L; int r = it % I_L;
            if (r < I_IN) { p0_transpose_item(args.in[3] + (size_t)l * D_MODEL * N_IN, D_MODEL, N_IN, WT_IN(l), D_MODEL, scr, r, lane); continue; } r -= I_IN;
            if (r < I_A) { p0_transpose_item(args.in[13] + (size_t)l * W_A * D_MODEL, W_A, D_MODEL, WT_A(l) + Y_A, D_MODEL, scr, r, lane); continue; } r -= I_A;
            if (r < I_B) { p0_transpose_item(args.in[14] + (size_t)l * W_B * D_MODEL, W_B, D_MODEL, WT_A(l) + Y_B, D_MODEL, scr, r, lane); continue; } r -= I_B;
            if (r < I_M) { p0_transpose_item(args.in[15] + (size_t)l * W_M * D_MODEL, W_M, D_MODEL, WT_A(l) + Y_M, D_MODEL, scr, r, lane); continue; } r -= I_M;
            if (r < I_O) { p0_transpose_item(args.in[16] + (size_t)l * D_MODEL * D_MODEL, D_MODEL, D_MODEL, WT_O(l), D_MODEL, scr, r, lane); continue; } r -= I_O;
            p0_transpose_item(args.in[10] + (size_t)l * D_MODEL * (2 * W_M), D_MODEL, 2 * W_M, WT_MEM(l), D_MODEL, scr, r, lane);
        }
        for (int m = gw; m < DEPTH * MMEM; m += NGW) { const int l = m / MMEM, r = m % MMEM;
            rms_row_to_bf16(args.in[1] + (size_t)r * D_MODEL, args.in[9] + (size_t)l * D_MODEL, MEMN + (size_t)m * D_MODEL, lane); }
        for (int m = gw; m < MTOK; m += NGW) { scale_row_to_bf16(args.in[0] + (size_t)m * D_MODEL, args.in[2], Hb + (size_t)m * D_MODEL, SSQ + m, lane); if (lane == 0) SSQ[MTOK + m] = 0.f; }
    }
    TS_END(0);
    if (args.ws == nullptr) grid.sync();
    GSYNC();

    for (int it = 0; it <= 4; ++it) {
        const int l = (it >> 1) & 1, half = it & 1;
        TS_BEGIN(1);
        if (it == 0) {
            for (int ll = 0; ll < DEPTH; ++ll) {
                pg8::Gemm g{MEMN + (size_t)ll * MMEM * D_MODEL, WT_MEM(ll), MMEM, 2 * W_M, D_MODEL, D_MODEL, D_MODEL};
                pg8::StaticOrder S; S.init(MMEM, 2 * W_M, G, (bx + 32 * ll) % G);
                pg8::EpiBf16 E{MKV + (size_t)ll * MMEM * (2 * W_M), 2 * W_M};
                pg8::gemm_phase<pg8::EpiBf16>(lds, g, S, E);
            }
        }
        if (it >= 1) {
            const int pl = ((it - 1) >> 1) & 1, ph = (it - 1) & 1;
            pg8::Gemm g{MERGED, WT_O(pl), MHALF, D_MODEL, D_MODEL, D_MODEL, D_MODEL};
            pg8::StaticOrder S; S.init(MHALF, D_MODEL, G, bx, WGM_P4);
            pg8::EpiResid E{args.in[0] + (size_t)ph * MHALF * D_MODEL, out + (size_t)ph * MHALF * D_MODEL, Hb + (size_t)ph * MHALF * D_MODEL, args.in[2] + D_MODEL, SSQ + MTOK + (size_t)ph * MHALF, pl == 0 ? 1 : 0};
            for (int rep = 0; rep < (pl == 0 ? REP_P4 : 1); ++rep) pg8::gemm_phase<pg8::EpiResid>(lds, g, S, E);
        }
        TS_END(1);
        if (it == 4) break;
        TS_BEGIN(2);
        for (int rep = 0; rep < REP_P1; ++rep) {
            pg8::Gemm g{Hb + (size_t)half * MHALF * D_MODEL, WT_IN(l), MHALF, N_IN, D_MODEL, D_MODEL, D_MODEL};
            pg8::StaticOrder S; S.init(MHALF, N_IN, G, bx, WGM_P1);
            pg8::EpiProj E{PROJ, PJW, args.in[4] + (size_t)l * 3 * D_MODEL, GT, SSQ + (size_t)l * MTOK + (size_t)half * MHALF, args.in[7] + (size_t)l * HEAD_DIM, (LAS float*)(lds + LDS_XL)};
            pg8::gemm_phase<pg8::EpiProj>(lds, g, S, E);
        }
        TS_END(2);
        GSYNC();
        TS_BEGIN(3);
        for (int rep = 0; rep < REP_B; ++rep) {
            for (int rp = 0; rp < REP_CA * REP_CA0; ++rp)
            for (int u = vcu; u < 4 * H_B * 16; u += G) {
                const int qb = u & 15, hd = (u >> 4) & 7, bb = u >> 7;
                const int n0 = 4 * qb, jstart = (8 - n0) > 0 ? (8 - n0) : 0;
                at::attn_unit<true, false>(lds, PJB(C_Q + hd * HEAD_DIM), PJB(C_BZ + hd * HEAD_DIM), HEAD_DIM, YB + Y_B + hd * HEAD_DIM, D_MODEL, PJB(C_K + hd * HEAD_DIM), PJB(C_V + hd * HEAD_DIM), HEAD_DIM,
                                    bb * SEQ + qb * 256, bb * SEQ + (n0 - 8) * CHUNK, jstart, (REP_CA0 == 2 && rp == 0) ? jstart : 12,
                                    args.in[6] + (size_t)l * HEAD_DIM, args.in[7] + (size_t)l * HEAD_DIM, args.in[8] + (size_t)l * 513 * H_B + hd);
            }
            for (int rp = 0; rp < REP_MA * REP_MA0; ++rp)
            for (int u = vcu; u < 4 * H_M * 16; u += G) {
                const int qb = u & 15, hd = (u >> 4) & 3, bb = u >> 6;
                const bf16_t* kv = MKV + (size_t)l * MMEM * (2 * W_M) + hd * HEAD_DIM;
                at::attn_unit<false, true>(lds, PJB(C_MQ + hd * HEAD_DIM), PJB(C_MZ + hd * HEAD_DIM), HEAD_DIM, YB + Y_M + hd * HEAD_DIM, D_MODEL, kv, kv + W_M, 2 * W_M,
                                     bb * SEQ + qb * 256, (half * 4 + bb) * MEM_LEN, 0, (REP_MA0 == 2 && rp == 0) ? 0 : 4,
                                     args.in[11] + (size_t)l * HEAD_DIM, args.in[12] + (size_t)l * HEAD_DIM, args.in[8]);
            }
            {
                int lane_ = threadIdx.x & 63; asm volatile("" : "+v"(lane_)); const int lane = lane_;
                const float* cw = args.in[5] + (size_t)l * 3 * W_A + 8 * lane;
                f32x4 wv[3][2];
#pragma unroll
                for (int tp = 0; tp < 3; ++tp) { wv[tp][0] = *(const f32x4*)(cw + tp * W_A); wv[tp][1] = *(const f32x4*)(cw + tp * W_A + 4); }
                for (int rp = 0; rp < REP_CV; ++rp)
                for (int r = gw; r < MHALF; r += NGW) {
                    const int t = r & (SEQ - 1);
                    const bf16_t* base = PROJ + ((size_t)(lane >> 4) * MHALF + r) * 128 + 8 * (lane & 15);
                    const u32x4 ab = *(const u32x4*)(base + (size_t)C_AB * MHALF), az = *(const u32x4*)(base + (size_t)C_AZ * MHALF);
                    float acc[8];
#pragma unroll
                    for (int k = 0; k < 8; ++k) acc[k] = 0.f;
#pragma unroll
                    for (int tp = 0; tp < 3; ++tp) {
                        const int dt = 2 - tp;
                        if (t >= dt) {
                            const bf16_t* pb = base - (size_t)dt * 128;
                            const u32x4 ac = *(const u32x4*)(pb + (size_t)C_AC * MHALF), ax = *(const u32x4*)(pb + (size_t)C_AX * MHALF);
#pragma unroll
                            for (int k = 0; k < 4; ++k) { acc[2 * k] += wv[tp][k >> 1][(2 * k) & 3] * bflo(ac[k]) * bflo(ax[k]); acc[2 * k + 1] += wv[tp][k >> 1][(2 * k + 1) & 3] * bfhi(ac[k]) * bfhi(ax[k]); }
                        }
                    }
                    u32x4 o;
#pragma unroll
                    for (int k = 0; k < 4; ++k) o[k] = pk2(bflo(ab[k]) * acc[2 * k] * bflo(az[k]), bfhi(ab[k]) * acc[2 * k + 1] * bfhi(az[k]));
                    *(u32x4*)(YB + (size_t)r * D_MODEL + Y_A + 8 * lane) = o;
                }
            }
        }
        TS_END(3);
        GSYNC();
        TS_BEGIN(4);
        for (int rep = 0; rep < REP_C; ++rep) {
            pg8::StaticOrder S; S.init(MHALF, D_MODEL, G, bx, WGM_C);
            pg8::Gemm g{YB, WT_A(l), MHALF, D_MODEL, D_MODEL, D_MODEL, D_MODEL};
            pg8::EpiGateFinal E{GT, MERGED};
            pg8::HookGate HK{GT};
            pg8::gemm_phase<pg8::EpiGateFinal, pg8::HookGate>(lds, g, S, E, HK);
        }
        TS_END(4);
        GSYNC();
    }
#ifdef PROBE_SEL
    grid.sync();
    if (bx == 0 && tid == 0) out[0] = (float)tacc * 0.01f;
#endif
}

extern "C" void kernel_launch(void* const* d_in, const int* in_sizes, int n_in, void* d_out, int out_size, void* d_ws, size_t ws_size, hipStream_t stream) {
    static int grid_blocks = 0;
    if (grid_blocks == 0) {
        if (n_in != 17 || in_sizes[0] != MTOK * D_MODEL || out_size != MTOK * D_MODEL || ws_size < WS_END) {
            fprintf(stderr, "kernel_launch: unexpected shapes (n_in %d, in0 %d, out %d, ws %zu < %zu); nothing launched\n", n_in, n_in > 0 ? in_sizes[0] : -1, out_size, ws_size, (size_t)WS_END);
            grid_blocks = -1; return; }
        int dev = 0, cus = 0, per_cu = 0;
        hipGetDevice(&dev);
        hipDeviceGetAttribute(&cus, hipDeviceAttributeMultiprocessorCount, dev);
        hipFuncSetAttribute((const void*)fwd_megakernel, hipFuncAttributeMaxDynamicSharedMemorySize, LDS_BYTES);
        hipOccupancyMaxActiveBlocksPerMultiprocessor(&per_cu, (const void*)fwd_megakernel, NTHREADS, LDS_BYTES);
        if (per_cu < 1) per_cu = 1;
        grid_blocks = cus * per_cu;
        (void)hipGetLastError();
    }
    if (grid_blocks < 0) return;
    if (hipMemsetAsync((char*)d_ws + WS_CTL, 0, CTL_ZERO_BYTES, stream) != hipSuccess) { fprintf(stderr, "kernel_launch: memset of barrier words failed\n"); return; }
    Args a{};
    for (int i = 0; i < 17; ++i) a.in[i] = (const float*)d_in[i];
    a.out = (float*)d_out; a.ws = (unsigned char*)d_ws;
    void* kargs[] = {&a};
    hipError_t e = hipLaunchCooperativeKernel((const void*)fwd_megakernel, dim3(grid_blocks), dim3(NTHREADS), kargs, LDS_BYTES, stream);
    if (e != hipSuccess) fprintf(stderr, "cooperative launch failed: %s (grid %d)\n", hipGetErrorString(e), grid_blocks);
}
```

```cpp
#include <hip/hip_runtime.h>
#include <hip/hip_cooperative_groups.h>
#include <cstdio>
#include <cstdint>
namespace cg = cooperative_groups;

#define LAS __attribute__((address_space(3)))
typedef unsigned short bf16_t;
typedef short bf16x8 __attribute__((ext_vector_type(8)));
typedef short s16x4 __attribute__((ext_vector_type(4)));
typedef float f32x4 __attribute__((ext_vector_type(4)));
typedef float f32x16 __attribute__((ext_vector_type(16)));
typedef unsigned u32x4 __attribute__((ext_vector_type(4)));
typedef unsigned u32x2 __attribute__((ext_vector_type(2)));
typedef float f32x2_t __attribute__((ext_vector_type(2)));
typedef __bf16 bf16x2_t __attribute__((ext_vector_type(2)));

constexpr int D_MODEL = 2048, BATCH = 8, SEQ = 4096, DEPTH = 2, CHUNK = 64, MEM_LEN = 256, HEAD_DIM = 128;
constexpr int W_A = 512, W_B = 1024, W_M = 512, H_B = 8, H_M = 4, N_IN = 13312;
constexpr int MTOK = BATCH * SEQ;
constexpr int MHALF = MTOK / 2;
constexpr int MMEM = BATCH * MEM_LEN;
constexpr float EPS = 1e-6f;
constexpr float LOG2E = 1.4426950408889634f;
constexpr int PJW = 7168;
constexpr int C_AB = 0, C_AC = 512, C_AX = 1024, C_AZ = 1536, C_Q = 2048, C_K = 3072, C_V = 4096, C_BZ = 5120, C_MQ = 6144, C_MZ = 6656, C_GA = 7168, C_GB = 9216, C_GM = 11264;

__device__ __forceinline__ unsigned pk2(float lo, float hi) { f32x2_t v = {lo, hi}; bf16x2_t b = __builtin_convertvector(v, bf16x2_t); return __builtin_bit_cast(unsigned, b); }
__device__ __forceinline__ float bflo(unsigned w) { return __uint_as_float(w << 16); }
__device__ __forceinline__ float bfhi(unsigned w) { return __uint_as_float(w & 0xffff0000u); }
__device__ __forceinline__ float sigmoidf_(float v) { return __builtin_amdgcn_rcpf(1.0f + __builtin_amdgcn_exp2f(-v * LOG2E)); }
__device__ __forceinline__ float row16_sum(float v) {
    v += __uint_as_float(__builtin_amdgcn_update_dpp(0u, __float_as_uint(v), 0xB1, 0xF, 0xF, true));
    v += __uint_as_float(__builtin_amdgcn_update_dpp(0u, __float_as_uint(v), 0x4E, 0xF, 0xF, true));
    v += __uint_as_float(__builtin_amdgcn_update_dpp(0u, __float_as_uint(v), 0x124, 0xF, 0xF, true));
    v += __uint_as_float(__builtin_amdgcn_update_dpp(0u, __float_as_uint(v), 0x128, 0xF, 0xF, true));
    return v;
}
__device__ __forceinline__ float half_sum(float v) { auto rr = __builtin_amdgcn_permlane32_swap(__float_as_uint(v), __float_as_uint(v), false, false); return __uint_as_float(rr[0]) + __uint_as_float(rr[1]); }
__device__ __forceinline__ float half_max(float v) { auto rr = __builtin_amdgcn_permlane32_swap(__float_as_uint(v), __float_as_uint(v), false, false); return fmaxf(__uint_as_float(rr[0]), __uint_as_float(rr[1])); }
__device__ __forceinline__ float wave_sum(float v) {
#pragma unroll
    for (int o = 1; o < 64; o <<= 1) v += __shfl_xor(v, o);
    return v;
}

namespace pg8 {
constexpr int BM = 256, BK = 64, HALF = 128, HTB = HALF * BK * 2, STAGE_BYTES = 8 * HTB, NXCD = 8, WGM = 8;
__host__ __device__ __forceinline__ int lds_byte(int r, int c) { const int st = (r >> 4) * 2 + (c >> 5), rr = r & 15, cc = c & 31, ob = rr * 64 + cc * 2; return st * 1024 + (ob ^ (((ob >> 9) & 1) << 5)); }
__host__ __device__ __forceinline__ void stage_rc(int b, int& R, int& C) { const int st = b / 1024, sb = b % 1024, swz = sb ^ (((sb >> 9) & 1) << 5); R = (st >> 1) * 16 + swz / 64; C = (st & 1) * 32 + (swz % 64) / 2; }
__host__ __device__ __forceinline__ int perm32(int rho) { const int n = rho >> 4, i = rho & 15; return 8 * (i >> 2) + 4 * n + (i & 3); }

struct Unit { int pm, pn; };
__device__ __forceinline__ unsigned gt_off(int br, int pm, int pn, int wid, int lane) { return (unsigned)(((br * 64 + pm) * 8 + pn) * 65536 + wid * 8192 + lane * 8); }
__device__ __forceinline__ float ub(unsigned w, int k) { return (float)((w >> (8 * k)) & 0xffu); }
struct Gemm { const bf16_t* A; const bf16_t* Bt; int M, N, K, lda, ldb; };

struct StaticOrder {
    int nM, nN, nwg, G, c, wgm;
    __device__ void init(int M, int N, int G_, int c_, int wgm_ = WGM) { nM = M / BM; nN = N / BM; nwg = nM * nN; G = G_; c = c_; wgm = wgm_; }
    __device__ bool next(int i, Unit& u) const {
        const long L = (long)i * G + c; if (L >= nwg) return false;
        int wgid = (int)L; { const int q = nwg / NXCD, r = nwg % NXCD, xcd = wgid % NXCD, off = wgid / NXCD; wgid = (xcd < r ? xcd * (q + 1) : r * (q + 1) + (xcd - r) * q) + off; }
        const int nig = wgm * nN, gid = wgid / nig, fm = gid * wgm, gsz = (nM - fm) < wgm ? (nM - fm) : wgm;
        u.pm = fm + ((wgid % nig) % gsz); u.pn = (wgid % nig) / gsz; return true;
    }
};

struct EpiBf16 {
    static constexpr bool PERM = true;
    bf16_t* O; int ldc;
    __device__ __forceinline__ void operator()(const f32x4 (&acc)[2][2][4][2], const Unit& u, int wr, int wc, int fr, int fq) const {
        const int row0 = u.pm * BM + wr * 64 + fr, col0 = u.pn * BM + wc * 32 + 8 * fq;
#pragma unroll
        for (int ai = 0; ai < 2; ++ai)
#pragma unroll
            for (int m = 0; m < 4; ++m) { bf16_t* rowp = O + (size_t)(row0 + ai * HALF + m * 16) * ldc + col0;
#pragma unroll
                for (int bj = 0; bj < 2; ++bj) { const f32x4 v0 = acc[ai][bj][m][0], v1 = acc[ai][bj][m][1];
                    u32x4 w; w.x = pk2(v0[0], v0[1]); w.y = pk2(v0[2], v0[3]); w.z = pk2(v1[0], v1[1]); w.w = pk2(v1[2], v1[3]);
                    *(u32x4*)(rowp + bj * HALF) = w; } }
    }
};
struct EpiProj {
    static constexpr bool PERM = true;
    bf16_t* O; int ldc; const float* bgate; bf16_t* GT; const float* ssq;
    const float* gk; LAS float* xl;
    __device__ __forceinline__ void operator()(const f32x4 (&acc)[2][2][4][2], const Unit& u, int wr, int wc, int fr, int fq) const {
        const int colt = u.pn * BM;
        int mode = 0;
        if (colt >= C_GA) mode = 2; else if ((colt >= C_AZ && colt < C_Q) || (colt >= C_BZ && colt < C_MQ) || (colt >= C_MZ)) mode = 1;
        const bool knorm = (colt >= C_K && colt < C_V);
        const int row0 = u.pm * BM + wr * 64 + fr, col0 = colt + wc * 32 + 8 * fq;
        f32x4 bv[2][2];
#pragma unroll
        for (int bj = 0; bj < 2; ++bj)
#pragma unroll
            for (int n = 0; n < 2; ++n) bv[bj][n] = (mode == 2) ? *(const f32x4*)(bgate + (col0 - C_GA) + bj * HALF + 4 * n) : (f32x4){0.f, 0.f, 0.f, 0.f};
        float rk[2][4][2];
        f32x4 gkv[2];
        if (knorm) {
            gkv[0] = *(const f32x4*)(gk + wc * 32 + 8 * fq); gkv[1] = *(const f32x4*)(gk + wc * 32 + 8 * fq + 4);
#pragma unroll
            for (int ai = 0; ai < 2; ++ai)
#pragma unroll
                for (int m = 0; m < 4; ++m) { const float rstd = rsqrtf(ssq[row0 + ai * HALF + m * 16] * (1.0f / D_MODEL) + EPS);
#pragma unroll
                    for (int bj = 0; bj < 2; ++bj) { const f32x4 v0 = acc[ai][bj][m][0] * rstd, v1 = acc[ai][bj][m][1] * rstd;
                        float sq = (v0[0] * v0[0] + v0[1] * v0[1]) + (v0[2] * v0[2] + v0[3] * v0[3]) + (v1[0] * v1[0] + v1[1] * v1[1]) + (v1[2] * v1[2] + v1[3] * v1[3]);
                        sq += __shfl_xor(sq, 16); sq += __shfl_xor(sq, 32);
                        if (fq == 0) xl[((ai * HALF + wr * 64 + m * 16 + fr) * 2 + bj) * 4 + wc] = sq; } }
            asm volatile("s_waitcnt lgkmcnt(0)\n\ts_barrier" ::: "memory");
#pragma unroll
            for (int ai = 0; ai < 2; ++ai)
#pragma unroll
                for (int m = 0; m < 4; ++m)
#pragma unroll
                    for (int bj = 0; bj < 2; ++bj) { const f32x4 t = *(const LAS f32x4*)(xl + ((ai * HALF + wr * 64 + m * 16 + fr) * 2 + bj) * 4);
                        rk[ai][m][bj] = rsqrtf(((t[0] + t[1]) + (t[2] + t[3])) * (1.0f / HEAD_DIM) + EPS); }
        }
#pragma unroll
        for (int ai = 0; ai < 2; ++ai)
#pragma unroll
            for (int m = 0; m < 4; ++m) { bf16_t* rowp = O + ((size_t)(colt >> 7) * MHALF + (row0 + ai * HALF + m * 16)) * 128 + wc * 32 + 8 * fq;
                const float rstd = rsqrtf(ssq[row0 + ai * HALF + m * 16] * (1.0f / D_MODEL) + EPS);
#pragma unroll
                for (int bj = 0; bj < 2; ++bj) { f32x4 v0 = acc[ai][bj][m][0] * rstd + bv[bj][0], v1 = acc[ai][bj][m][1] * rstd + bv[bj][1];
                    if (mode != 0) {
                        const float nr = -LOG2E * rstd;
#pragma unroll
                        for (int e = 0; e < 4; ++e) {
                            const float s0 = __builtin_amdgcn_rcpf(1.0f + __builtin_amdgcn_exp2f(__builtin_fmaf(acc[ai][bj][m][0][e], nr, -LOG2E * bv[bj][0][e])));
                            const float s1 = __builtin_amdgcn_rcpf(1.0f + __builtin_amdgcn_exp2f(__builtin_fmaf(acc[ai][bj][m][1][e], nr, -LOG2E * bv[bj][1][e])));
                            v0[e] = (mode == 1) ? v0[e] * s0 : s0; v1[e] = (mode == 1) ? v1[e] * s1 : s1; }
                    }
                    if (knorm) { v0 = v0 * rk[ai][m][bj] * gkv[0]; v1 = v1 * rk[ai][m][bj] * gkv[1]; }
                    if (mode == 2) { u32x2 q; q.x = 0u; q.y = 0u;
#pragma unroll
                        for (int e = 0; e < 4; ++e) { q.x = __builtin_amdgcn_cvt_pk_u8_f32(fmaxf(__builtin_rintf(v0[e] * 255.0f), 1.0f), e, q.x); q.y = __builtin_amdgcn_cvt_pk_u8_f32(fmaxf(__builtin_rintf(v1[e] * 255.0f), 1.0f), e, q.y); }
                        *(u32x2*)((char*)GT + gt_off((colt - C_GA) >> 11, u.pm, ((colt - C_GA) & 2047) >> 8, wr * 4 + wc, fq * 16 + fr) + (unsigned)(((ai * 4 + m) * 2 + bj) * 512)) = q; }
                    else { u32x4 w; w.x = pk2(v0[0], v0[1]); w.y = pk2(v0[2], v0[3]); w.z = pk2(v1[0], v1[1]); w.w = pk2(v1[2], v1[3]);
                        *(u32x4*)(rowp + (size_t)bj * MHALF * 128) = w; } } }
    }
};
struct NoHook { static constexpr bool ON = false; __device__ __forceinline__ void operator()(f32x4 (&)[2][2][4][2], const Unit&, int, int, int, int, int) const {} };
struct HookGate {
    static constexpr bool ON = true;
    const bf16_t* GT;
    __device__ __forceinline__ void operator()(f32x4 (&acc)[2][2][4][2], const Unit& u, int t, int wr, int wc, int fr, int fq) const {
        if (t != W_A / BK && t != (W_A + W_B) / BK) return;
        const int b1 = (t == W_A / BK) ? 0 : 1;
        unsigned o1 = gt_off(b1, u.pm, u.pn, wr * 4 + wc, fq * 16 + fr); asm volatile("" : "+v"(o1));
        const unsigned o2 = o1 + 64u * 8u * 65536u;
        u32x2 g1[2][4][2], g2[2][4][2];
#pragma unroll
        for (int ai = 0; ai < 2; ++ai)
#pragma unroll
            for (int m = 0; m < 4; ++m)
#pragma unroll
                for (int bj = 0; bj < 2; ++bj) { const unsigned off = (unsigned)(((ai * 4 + m) * 2 + bj) * 512);
                    g1[ai][m][bj] = *(const u32x2*)((const char*)GT + o1 + off); g2[ai][m][bj] = *(const u32x2*)((const char*)GT + o2 + off); }
#pragma unroll
        for (int ai = 0; ai < 2; ++ai)
#pragma unroll
            for (int m = 0; m < 4; ++m)
#pragma unroll
                for (int bj = 0; bj < 2; ++bj)
#pragma unroll
                    for (int n = 0; n < 2; ++n)
#pragma unroll
                        for (int e = 0; e < 4; ++e) acc[ai][bj][m][n][e] *= ub(g1[ai][m][bj][n], e) * __builtin_amdgcn_rcpf(ub(g2[ai][m][bj][n], e));
        asm volatile("" ::: "memory");
    }
};
struct EpiGateFinal {
    static constexpr bool PERM = true;
    const bf16_t* GT; bf16_t* MG;
    __device__ __forceinline__ void operator()(const f32x4 (&acc)[2][2][4][2], const Unit& u, int wr, int wc, int fr, int fq) const {
        const int row0 = u.pm * BM + wr * 64 + fr, col0 = u.pn * BM + wc * 32 + 8 * fq;
        const unsigned ob = (unsigned)(row0 * D_MODEL + col0) * 2u, og = gt_off(2, u.pm, u.pn, wr * 4 + wc, fq * 16 + fr);
        u32x2 gg[2][4][2];
#pragma unroll
        for (int ai = 0; ai < 2; ++ai)
#pragma unroll
            for (int m = 0; m < 4; ++m)
#pragma unroll
                for (int bj = 0; bj < 2; ++bj) gg[ai][m][bj] = *(const u32x2*)((const char*)GT + og + (unsigned)(((ai * 4 + m) * 2 + bj) * 512));
        constexpr float S = 1.0f / 255.0f;
#pragma unroll
        for (int ai = 0; ai < 2; ++ai)
#pragma unroll
            for (int m = 0; m < 4; ++m)
#pragma unroll
                for (int bj = 0; bj < 2; ++bj) { const u32x2 g = gg[ai][m][bj];
                    const f32x4 a0 = acc[ai][bj][m][0] * S, a1 = acc[ai][bj][m][1] * S;
                    u32x4 w; w.x = pk2(ub(g.x, 0) * a0[0], ub(g.x, 1) * a0[1]); w.y = pk2(ub(g.x, 2) * a0[2], ub(g.x, 3) * a0[3]);
                    w.z = pk2(ub(g.y, 0) * a1[0], ub(g.y, 1) * a1[1]); w.w = pk2(ub(g.y, 2) * a1[2], ub(g.y, 3) * a1[3]);
                    *(u32x4*)((char*)MG + ob + (unsigned)((ai * HALF + m * 16) * D_MODEL + bj * HALF) * 2u) = w; }
    }
};
struct EpiResid {
    static constexpr bool PERM = true;
    const float* base; float* out; bf16_t* hbuf; const float* gnext; float* ssq; int first;
    __device__ __forceinline__ void operator()(const f32x4 (&acc)[2][2][4][2], const Unit& u, int wr, int wc, int fr, int fq) const {
        const int row0 = u.pm * BM + wr * 64 + fr, col0 = u.pn * BM + wc * 32 + 8 * fq;
        const unsigned ob = (unsigned)(row0 * D_MODEL + col0) * 4u;
        const bool hx = (first != 0);
        f32x4 gv[2][2];
#pragma unroll
        for (int bj = 0; bj < 2; ++bj)
#pragma unroll
            for (int n = 0; n < 2; ++n) { gv[bj][n] = *(const f32x4*)(gnext + col0 + bj * HALF + 4 * n);
                if (!hx) { gv[bj][n][0] = 1.0f / gv[bj][n][0]; gv[bj][n][1] = 1.0f / gv[bj][n][1]; gv[bj][n][2] = 1.0f / gv[bj][n][2]; gv[bj][n][3] = 1.0f / gv[bj][n][3]; } }
#pragma unroll
        for (int ai = 0; ai < 2; ++ai) {
            f32x4 bb[4][2][2];
            if (hx) {
#pragma unroll
                for (int mm = 0; mm < 4; ++mm)
#pragma unroll
                    for (int bj = 0; bj < 2; ++bj)
#pragma unroll
                        for (int n = 0; n < 2; ++n) bb[mm][bj][n] = *(const f32x4*)((const char*)base + ob + (unsigned)((ai * HALF + mm * 16) * D_MODEL + bj * HALF + n * 4) * 4u);
            } else {
                u32x4 hw[4][2];
#pragma unroll
                for (int mm = 0; mm < 4; ++mm)
#pragma unroll
                    for (int bj = 0; bj < 2; ++bj) hw[mm][bj] = *(const u32x4*)((const char*)hbuf + (ob >> 1) + (unsigned)((ai * HALF + mm * 16) * D_MODEL + bj * HALF) * 2u);
#pragma unroll
                for (int mm = 0; mm < 4; ++mm)
#pragma unroll
                    for (int bj = 0; bj < 2; ++bj) { const u32x4 h = hw[mm][bj];
                        bb[mm][bj][0] = (f32x4){bflo(h.x) * gv[bj][0][0], bfhi(h.x) * gv[bj][0][1], bflo(h.y) * gv[bj][0][2], bfhi(h.y) * gv[bj][0][3]};
                        bb[mm][bj][1] = (f32x4){bflo(h.z) * gv[bj][1][0], bfhi(h.z) * gv[bj][1][1], bflo(h.w) * gv[bj][1][2], bfhi(h.w) * gv[bj][1][3]}; }
            }
#pragma unroll
            for (int mm = 0; mm < 4; ++mm) {
                float sq = 0.f;
#pragma unroll
                for (int bj = 0; bj < 2; ++bj) {
                    const f32x4 x0 = bb[mm][bj][0] + acc[ai][bj][mm][0], x1 = bb[mm][bj][1] + acc[ai][bj][mm][1];
                    const unsigned eo = (unsigned)((ai * HALF + mm * 16) * D_MODEL + bj * HALF);
                    if (hx) {
                        sq += (x0[0] * x0[0] + x0[1] * x0[1]) + (x0[2] * x0[2] + x0[3] * x0[3]) + (x1[0] * x1[0] + x1[1] * x1[1]) + (x1[2] * x1[2] + x1[3] * x1[3]);
                        u32x4 w; w.x = pk2(x0[0] * gv[bj][0][0], x0[1] * gv[bj][0][1]); w.y = pk2(x0[2] * gv[bj][0][2], x0[3] * gv[bj][0][3]);
                        w.z = pk2(x1[0] * gv[bj][1][0], x1[1] * gv[bj][1][1]); w.w = pk2(x1[2] * gv[bj][1][2], x1[3] * gv[bj][1][3]);
                        *(u32x4*)((char*)hbuf + (ob >> 1) + eo * 2u) = w;
                    } else {
                        *(f32x4*)((char*)out + ob + eo * 4u) = x0; *(f32x4*)((char*)out + ob + eo * 4u + 16u) = x1;
                    }
                }
                if (hx) { sq += __shfl_xor(sq, 16); sq += __shfl_xor(sq, 32);
                    if (fq == 0) atomicAdd(ssq + row0 + ai * HALF + mm * 16, sq); }
            }
            asm volatile("" ::: "memory"); }
    }
};

template <class Epi, class Hook = NoHook>
__device__ __forceinline__ void gemm_phase(LAS unsigned char* lds, const Gemm g, const StaticOrder& S, const Epi& E, const Hook& HK = Hook()) {
    int tid_ = threadIdx.x; asm volatile("" : "+v"(tid_));
    const int tid = tid_, wid = __builtin_amdgcn_readfirstlane(tid >> 6), lane = tid & 63, wr = wid >> 2, wc = wid & 3, fr = lane & 15, fq = lane >> 4;
    const int K = g.K, nt = K / BK;
    unsigned voffA[2], voffB[2];
#pragma unroll
    for (int i = 0; i < 2; ++i) { int R, C; stage_rc(tid * 16 + i * 8192, R, C); const int Rb = Epi::PERM ? ((R & ~31) + perm32(R & 31)) : R;
        voffA[i] = (unsigned)(R * g.lda + C) * 2u; voffB[i] = (unsigned)(Rb * g.ldb + C) * 2u; }
    const size_t kstep = (size_t)(BK * 2);
    const size_t hA = (size_t)HALF * g.lda * 2, hB = (size_t)HALF * g.ldb * 2;
    const size_t tA = 2 * hA, tB = 2 * hB;
    const unsigned ldsw = (unsigned)wid * 1024u;
    const int aoff = lds_byte(wr * 64 + fr, fq * 8), boff = lds_byte(wc * 32 + fr, fq * 8);
#define PG8_SA(b, h) (((b) * 2 + (h)) * HTB)
#define PG8_SB(b, h) ((4 + (b) * 2 + (h)) * HTB)
#define PG8_STAGE(bufoff, gbase, voff) do { _Pragma("unroll") for (int _i = 0; _i < 2; ++_i) \
        __builtin_amdgcn_global_load_lds((const unsigned*)((const char*)(gbase) + (voff)[_i]), (LAS unsigned*)(lds + (bufoff) + ldsw + _i * 8192), 16, 0, 0); } while (0)
#define PG8_LDA(dst, b, h) do { _Pragma("unroll") for (int m = 0; m < 4; ++m) _Pragma("unroll") for (int k = 0; k < 2; ++k) dst[m][k] = *(const LAS bf16x8*)(lds + PG8_SA(b, h) + aoff + m * 2048 + k * 1024); } while (0)
#define PG8_LDB(dst, b, h) do { _Pragma("unroll") for (int n = 0; n < 2; ++n) _Pragma("unroll") for (int k = 0; k < 2; ++k) dst[n][k] = *(const LAS bf16x8*)(lds + PG8_SB(b, h) + boff + n * 2048 + k * 1024); } while (0)
#define PG8_MMA(ai, bj, At, Bt) do { __builtin_amdgcn_s_setprio(0); _Pragma("unroll") for (int m = 0; m < 4; ++m) _Pragma("unroll") for (int n = 0; n < 2; ++n) _Pragma("unroll") for (int k = 0; k < 2; ++k) \
        acc[ai][bj][m][n] = __builtin_amdgcn_mfma_f32_16x16x32_bf16(Bt[n][k], At[m][k], acc[ai][bj][m][n], 0, 0, 0); __builtin_amdgcn_s_setprio(0); } while (0)
#define PG8_WAIT_V(n) asm volatile("s_waitcnt vmcnt(" #n ")" ::: "memory")
#define PG8_WAIT_L(n) asm volatile("s_waitcnt lgkmcnt(" #n ")" ::: "memory")
#define PG8_BAR __builtin_amdgcn_s_barrier()
#define PG8_SCHED __builtin_amdgcn_sched_barrier(0)
    Unit cur, nxt; int ui = 0;
    if (!S.next(0, cur)) return;
    f32x4 acc[2][2][4][2];
#pragma unroll
    for (int a = 0; a < 2; ++a)
#pragma unroll
        for (int b = 0; b < 2; ++b)
#pragma unroll
            for (int m = 0; m < 4; ++m)
#pragma unroll
                for (int n = 0; n < 2; ++n) acc[a][b][m][n] = (f32x4){0.f, 0.f, 0.f, 0.f};
    bf16x8 At[4][2], B0[2][2], B1[2][2];
    const char* cA = (const char*)g.A + (size_t)cur.pm * tA; const char* cB = (const char*)g.Bt + (size_t)cur.pn * tB;
    PG8_STAGE(PG8_SB(0, 0), cB, voffB); PG8_STAGE(PG8_SB(0, 1), cB + hB, voffB); PG8_STAGE(PG8_SA(0, 0), cA, voffA); PG8_STAGE(PG8_SA(0, 1), cA + hA, voffA);
    if (wr == 1) PG8_BAR;
    PG8_WAIT_V(2); PG8_BAR;
    PG8_STAGE(PG8_SB(1, 0), cB + kstep, voffB); PG8_STAGE(PG8_SA(1, 0), cA + kstep, voffA); PG8_STAGE(PG8_SB(1, 1), cB + hB + kstep, voffB);
    PG8_WAIT_V(6); PG8_BAR;
    for (;;) {
        const bool has_next = S.next(ui + 1, nxt);
        const char* nA = has_next ? (const char*)g.A + (size_t)nxt.pm * tA : cA; const char* nB = has_next ? (const char*)g.Bt + (size_t)nxt.pn * tB : cB;
        for (int t = 0; t < nt; t += 2) {
            const bool last = (t == nt - 2);
            const char* a1 = cA + (size_t)(t + 1) * kstep;
            const char* a2 = last ? nA : cA + (size_t)(t + 2) * kstep; const char* b2 = last ? nB : cB + (size_t)(t + 2) * kstep;
            const char* a3 = a2 + kstep; const char* b3 = b2 + kstep;
            if constexpr (Hook::ON) HK(acc, cur, t, wr, wc, fr, fq);
            PG8_LDB(B0, 0, 0); PG8_LDB(B1, 0, 1); PG8_SCHED; PG8_LDA(At, 0, 0); PG8_STAGE(PG8_SA(1, 1), a1 + hA, voffA);
            PG8_WAIT_V(8); PG8_WAIT_L(0); PG8_BAR; PG8_MMA(0, 0, At, B0); PG8_MMA(0, 1, At, B1); PG8_BAR; PG8_SCHED;
            PG8_LDA(At, 0, 1); PG8_STAGE(PG8_SB(0, 0), b2, voffB); PG8_STAGE(PG8_SB(0, 1), b2 + hB, voffB); PG8_STAGE(PG8_SA(0, 0), a2, voffA);
            PG8_WAIT_V(8); PG8_WAIT_L(0); PG8_BAR; PG8_MMA(1, 0, At, B0); PG8_MMA(1, 1, At, B1); PG8_BAR; PG8_SCHED;
            PG8_LDB(B0, 1, 0); PG8_LDB(B1, 1, 1); PG8_SCHED; PG8_LDA(At, 1, 0); PG8_STAGE(PG8_SA(0, 1), a2 + hA, voffA);
            PG8_WAIT_V(8); PG8_WAIT_L(0); PG8_BAR; PG8_MMA(0, 0, At, B0); PG8_MMA(0, 1, At, B1); PG8_BAR; PG8_SCHED;
            PG8_LDA(At, 1, 1); PG8_STAGE(PG8_SB(1, 0), b3, voffB); PG8_STAGE(PG8_SB(1, 1), b3 + hB, voffB); PG8_STAGE(PG8_SA(1, 0), a3, voffA);
            PG8_WAIT_V(8); PG8_WAIT_L(0); PG8_BAR; PG8_MMA(1, 0, At, B0); PG8_MMA(1, 1, At, B1); PG8_BAR; PG8_SCHED;
        }
        if (wr == 0) PG8_BAR;
        E(acc, cur, wr, wc, fr, fq);
        if (!has_next) break;
#pragma unroll
        for (int a = 0; a < 2; ++a)
#pragma unroll
            for (int b = 0; b < 2; ++b)
#pragma unroll
                for (int m = 0; m < 4; ++m)
#pragma unroll
                    for (int n = 0; n < 2; ++n) acc[a][b][m][n] = (f32x4){0.f, 0.f, 0.f, 0.f};
        cur = nxt; cA = nA; cB = nB; ++ui;
        if (wr == 1) PG8_BAR;
    }
    PG8_WAIT_V(0);
    PG8_BAR;
#undef PG8_SA
#undef PG8_SB
#undef PG8_STAGE
#undef PG8_LDA
#undef PG8_LDB
#undef PG8_MMA
#undef PG8_WAIT_V
#undef PG8_WAIT_L
#undef PG8_BAR
#undef PG8_SCHED
}
}

namespace at {
constexpr int KSTR = 272, VSTR = 320;
constexpr int AT_K = 0, AT_V = 2 * 64 * KSTR, AT_TAB = AT_V + 2 * 64 * VSTR, AT_END = AT_TAB + 640 * 4;
__device__ __forceinline__ s16x4 vtr(const LAS unsigned char* p) { return __builtin_bit_cast(s16x4, __builtin_amdgcn_ds_read_tr16_b64_v4i16((LAS s16x4*)p)); }

template <bool CH, bool KN>
__device__ __forceinline__ void attn_unit(LAS unsigned char* lds, const bf16_t* QO, const bf16_t* SZ, int ldq, bf16_t* OB, int ldo, const bf16_t* Kb, const bf16_t* Vb, int ldk,
                                          int q_row0, int k_row0, int jstart, int ntiles, const float* gq, const float* gk, const float* rel) {
    int tid_ = threadIdx.x; asm volatile("" : "+v"(tid_));
    const int tid = tid_, lane = tid & 63, w = __builtin_amdgcn_readfirstlane(tid >> 6), r32 = lane & 31, hh = lane >> 5;
    LAS float* tab = (LAS float*)(lds + AT_TAB);
    if (CH) { for (int e = tid; e < 640; e += 512) { int idx = e - 63; idx = idx < -256 ? -256 : (idx > 256 ? 256 : idx); tab[e] = rel[(idx + 256) * 8] * LOG2E; } }
    const int srow = tid >> 4, sc = tid & 15;
    const f32x4 gk0 = *(const f32x4*)(gk + 8 * sc), gk1 = *(const f32x4*)(gk + 8 * sc + 4);
    u32x4 kr[2], vr[2];
#define AT_GLOAD(j) do { const size_t ro_ = (size_t)(k_row0 + (j) * 64 + srow) * ldk + 8 * sc; \
        kr[0] = *(const u32x4*)(Kb + ro_); kr[1] = *(const u32x4*)(Kb + ro_ + (size_t)32 * ldk); vr[0] = *(const u32x4*)(Vb + ro_); vr[1] = *(const u32x4*)(Vb + ro_ + (size_t)32 * ldk); } while (0)
#define AT_SSTORE(buf) do { _Pragma("unroll") for (int i_ = 0; i_ < 2; ++i_) { const u32x4 kq = kr[i_]; u32x4 kn = kq; \
        if (KN) { float s_ = bflo(kq.x) * bflo(kq.x) + bfhi(kq.x) * bfhi(kq.x) + bflo(kq.y) * bflo(kq.y) + bfhi(kq.y) * bfhi(kq.y) + bflo(kq.z) * bflo(kq.z) + bfhi(kq.z) * bfhi(kq.z) + bflo(kq.w) * bflo(kq.w) + bfhi(kq.w) * bfhi(kq.w); \
        s_ = row16_sum(s_); \
        const float rk_ = rsqrtf(s_ * (1.0f / 128.0f) + EPS); \
        kn.x = pk2(bflo(kq.x) * rk_ * gk0[0], bfhi(kq.x) * rk_ * gk0[1]); kn.y = pk2(bflo(kq.y) * rk_ * gk0[2], bfhi(kq.y) * rk_ * gk0[3]); \
        kn.z = pk2(bflo(kq.z) * rk_ * gk1[0], bfhi(kq.z) * rk_ * gk1[1]); kn.w = pk2(bflo(kq.w) * rk_ * gk1[2], bfhi(kq.w) * rk_ * gk1[3]); } \
        *(LAS u32x4*)(lds + AT_K + (buf) * (64 * KSTR) + (srow + 32 * i_) * KSTR + 16 * sc) = kn; \
        *(LAS u32x4*)(lds + AT_V + (buf) * (64 * VSTR) + (srow + 32 * i_) * VSTR + 16 * sc) = vr[i_]; } } while (0)

    AT_GLOAD(jstart);
    const int qrow = q_row0 + 32 * w + r32;
    bf16x8 qf[8];
    {
        const bf16_t* qp = QO + (size_t)qrow * ldq + 8 * hh;
        u32x4 qraw[8];
#pragma unroll
        for (int ds = 0; ds < 8; ++ds) qraw[ds] = *(const u32x4*)(qp + 16 * ds);
        float ss = 0.f;
#pragma unroll
        for (int ds = 0; ds < 8; ++ds)
#pragma unroll
            for (int k = 0; k < 4; ++k) { const float a = bflo(qraw[ds][k]), b = bfhi(qraw[ds][k]); ss += a * a + b * b; }
        ss = half_sum(ss);
        const float rs = rsqrtf(ss * (1.0f / 128.0f) + EPS) * (0.08838834764831845f * LOG2E);
#pragma unroll
        for (int ds = 0; ds < 8; ++ds) {
            const f32x4 g0 = *(const f32x4*)(gq + 16 * ds + 8 * hh), g1 = *(const f32x4*)(gq + 16 * ds + 8 * hh + 4);
            u32x4 o;
            o.x = pk2(bflo(qraw[ds].x) * rs * g0[0], bfhi(qraw[ds].x) * rs * g0[1]); o.y = pk2(bflo(qraw[ds].y) * rs * g0[2], bfhi(qraw[ds].y) * rs * g0[3]);
            o.z = pk2(bflo(qraw[ds].z) * rs * g1[0], bfhi(qraw[ds].z) * rs * g1[1]); o.w = pk2(bflo(qraw[ds].w) * rs * g1[2], bfhi(qraw[ds].w) * rs * g1[3]);
            qf[ds] = __builtin_bit_cast(bf16x8, o);
        }
    }
    float mrun = -1e30f, lsum = 0.f;
    f32x16 o[4];
#pragma unroll
    for (int db = 0; db < 4; ++db)
#pragma unroll
        for (int i = 0; i < 16; ++i) o[db][i] = 0.f;
    AT_SSTORE(0);
    if (jstart + 1 < ntiles) AT_GLOAD(jstart + 1);
    __syncthreads();
#pragma unroll 1
    for (int j = jstart; j < ntiles; ++j) {
        const int buf = (j - jstart) & 1;
        const int jj = j - (w >> 1);
        const bool active = !CH || (jj >= 0 && jj <= 8);
        bf16x8 pf[2][2];
        if (active) {
            const LAS unsigned char* Kt = lds + AT_K + buf * (64 * KSTR) + r32 * KSTR + 16 * hh;
            f32x16 p0, p1;
            {
                bf16x8 kf[16];
#pragma unroll
                for (int ds = 0; ds < 8; ++ds) { kf[2 * ds] = *(const LAS bf16x8*)(Kt + 32 * ds); kf[2 * ds + 1] = *(const LAS bf16x8*)(Kt + 32 * KSTR + 32 * ds); }
                __builtin_amdgcn_sched_barrier(0);
                if (CH && jj <= 3) {
                    const float init = tab[638];
#pragma unroll
                    for (int i = 0; i < 16; ++i) { p0[i] = init; p1[i] = init; }
                    p0 = __builtin_amdgcn_mfma_f32_32x32x16_bf16(kf[0], qf[0], p0, 0, 0, 0);
                    p1 = __builtin_amdgcn_mfma_f32_32x32x16_bf16(kf[1], qf[0], p1, 0, 0, 0);
                } else {
                    const f32x16 zero16 = {0.f, 0.f, 0.f, 0.f, 0.f, 0.f, 0.f, 0.f, 0.f, 0.f, 0.f, 0.f, 0.f, 0.f, 0.f, 0.f};
                    p0 = __builtin_amdgcn_mfma_f32_32x32x16_bf16(kf[0], qf[0], zero16, 0, 0, 0);
                    p1 = __builtin_amdgcn_mfma_f32_32x32x16_bf16(kf[1], qf[0], zero16, 0, 0, 0);
                }
#pragma unroll
                for (int ds = 1; ds < 8; ++ds) {
                    p0 = __builtin_amdgcn_mfma_f32_32x32x16_bf16(kf[2 * ds], qf[ds], p0, 0, 0, 0);
                    p1 = __builtin_amdgcn_mfma_f32_32x32x16_bf16(kf[2 * ds + 1], qf[ds], p1, 0, 0, 0);
                }
            }
            if (CH && jj >= 4) {
                const LAS float* tb = tab + ((8 - jj) * 64 + 32 * (w & 1) + r32 - 4 * hh);
#pragma unroll
                for (int i = 0; i < 16; ++i) { p0[i] += tb[63 - (i & 3) - 8 * (i >> 2)]; p1[i] += tb[31 - (i & 3) - 8 * (i >> 2)]; }
            }
            float rm = __builtin_fmaxf(__builtin_fmaxf(p0[0], p1[0]), p0[1]);
#pragma unroll
            for (int i = 1; i < 15; ++i) rm = __builtin_fmaxf(__builtin_fmaxf(rm, p1[i]), p0[i + 1]);
            rm = half_max(__builtin_fmaxf(rm, p1[15]));
            const bool need = rm > mrun + 8.0f;
            if (__any(need)) {
                const float mn = need ? rm : mrun;
                const float alpha = __builtin_amdgcn_exp2f(mrun - mn);
                mrun = mn; lsum *= alpha;
#pragma unroll
                for (int db = 0; db < 4; ++db)
#pragma unroll
                    for (int i = 0; i < 16; ++i) o[db][i] *= alpha;
            }
            float ps = 0.f;
#pragma unroll
            for (int i = 0; i < 16; ++i) { p0[i] = __builtin_amdgcn_exp2f(p0[i] - mrun); p1[i] = __builtin_amdgcn_exp2f(p1[i] - mrun); ps += p0[i] + p1[i]; }
            lsum += ps;
#pragma unroll
            for (int s = 0; s < 2; ++s) {
                u32x4 a, b;
                a.x = pk2(p0[8 * s + 0], p0[8 * s + 1]); a.y = pk2(p0[8 * s + 2], p0[8 * s + 3]); a.z = pk2(p0[8 * s + 4], p0[8 * s + 5]); a.w = pk2(p0[8 * s + 6], p0[8 * s + 7]);
                b.x = pk2(p1[8 * s + 0], p1[8 * s + 1]); b.y = pk2(p1[8 * s + 2], p1[8 * s + 3]); b.z = pk2(p1[8 * s + 4], p1[8 * s + 5]); b.w = pk2(p1[8 * s + 6], p1[8 * s + 7]);
                pf[0][s] = __builtin_bit_cast(bf16x8, a); pf[1][s] = __builtin_bit_cast(bf16x8, b);
            }
        }
        if (j + 1 < ntiles) { AT_SSTORE(buf ^ 1); if (j + 2 < ntiles) AT_GLOAD(j + 2); }
        if (active) {
            const LAS unsigned char* Vt = lds + AT_V + buf * (64 * VSTR) + (4 * hh + ((lane & 15) >> 2)) * VSTR + (16 * ((lane >> 4) & 1) + 4 * (lane & 3)) * 2;
            s16x4 va[2][4][2];
#define AT_VLOAD(slot, g) do { _Pragma("unroll") for (int db_ = 0; db_ < 4; ++db_) { va[slot][db_][0] = vtr(Vt + (((g) >> 1) * 32 + 16 * ((g) & 1)) * VSTR + 64 * db_); va[slot][db_][1] = vtr(Vt + (((g) >> 1) * 32 + 16 * ((g) & 1) + 8) * VSTR + 64 * db_); } } while (0)
            AT_VLOAD(0, 0);
#pragma unroll
            for (int g = 0; g < 4; ++g) {
                if (g < 3) AT_VLOAD((g + 1) & 1, g + 1);
                __builtin_amdgcn_sched_barrier(0);
#pragma unroll
                for (int db = 0; db < 4; ++db) {
                    const bf16x8 vf = __builtin_shufflevector(va[g & 1][db][0], va[g & 1][db][1], 0, 1, 2, 3, 4, 5, 6, 7);
                    o[db] = __builtin_amdgcn_mfma_f32_32x32x16_bf16(vf, pf[g >> 1][g & 1], o[db], 0, 0, 0);
                }
                __builtin_amdgcn_sched_barrier(0);
            }
#undef AT_VLOAD
        }
        __syncthreads();
    }
#undef AT_GLOAD
#undef AT_SSTORE
    const float l = half_sum(lsum);
    const float inv = 1.0f / l;
    bf16_t* op = OB + (size_t)qrow * ldo + 4 * hh; const bf16_t* zp = SZ + (size_t)qrow * ldq + 4 * hh;
#pragma unroll
    for (int db = 0; db < 4; ++db)
#pragma unroll
        for (int g = 0; g < 4; ++g) {
            const int d = 32 * db + 8 * g;
            const u32x2 z = *(const u32x2*)(zp + d);
            u32x2 r;
            r.x = pk2(o[db][4 * g + 0] * inv * bflo(z.x), o[db][4 * g + 1] * inv * bfhi(z.x));
            r.y = pk2(o[db][4 * g + 2] * inv * bflo(z.y), o[db][4 * g + 3] * inv * bfhi(z.y));
            *(u32x2*)(op + d) = r;
        }
}
}


#define XB_TMO      128
#define XB_XCNT(j)  (256  + 64 * (j))
#define XB_XSUB(j)  (1280 + 64 * (j))
#define XB_XGEN(j)  (2304 + 64 * (j))
#define XB_TOP      3328
#define XB_TOPGEN   3392
#define XCD_BAR_WORDS 3456
#define XB_SPIN_CAP (1u << 18)
__device__ __forceinline__ unsigned xb_ld(unsigned* p)              { return __hip_atomic_load(p, __ATOMIC_RELAXED, __HIP_MEMORY_SCOPE_AGENT); }
__device__ __forceinline__ unsigned xb_add(unsigned* p, unsigned v) { return __hip_atomic_fetch_add(p, v, __ATOMIC_RELAXED, __HIP_MEMORY_SCOPE_AGENT); }
__device__ __forceinline__ unsigned xb_xcc_id() { return (unsigned)__builtin_amdgcn_s_getreg((3 << 11) | 20) & 0xFu; }
#define XB_SPIN(cond, bar) do { unsigned _sp = 0; while (cond) { __builtin_amdgcn_s_sleep(1); \
    if ((++_sp & 255u) == 0u) { if (xb_ld(&(bar)[XB_TMO])) break; if (_sp > XB_SPIN_CAP) { atomicAdd(&(bar)[XB_TMO], 1u); break; } } } } while (0)
struct XcdBarrier { unsigned* bar; unsigned x; volatile LAS unsigned* st; };
__device__ __forceinline__ XcdBarrier xcd_barrier_post(unsigned* bar, volatile LAS unsigned* st) {
    XcdBarrier b; b.bar = bar; b.x = xb_xcc_id(); b.st = st;
    if (threadIdx.x == 0) (void)xb_add(&bar[XB_XCNT(b.x)], 1u);
    return b;
}
__device__ __forceinline__ void xcd_barrier_complete(unsigned* bar, unsigned x, unsigned& nloc, unsigned& nx) {
    const unsigned G = gridDim.x * gridDim.y * gridDim.z;
    unsigned sum, cnt, mine, sp = 0u;
    for (;;) {
        sum = 0u; cnt = 0u; mine = 0u;
#pragma unroll
        for (unsigned j = 0; j < 16; ++j) { const unsigned c = xb_ld(&bar[XB_XCNT(j)]); sum += c; cnt += (c > 0u) ? 1u : 0u; mine = (j == x) ? c : mine; }
        if (sum == G) break;
        __builtin_amdgcn_s_sleep(1);
        if ((++sp & 255u) == 0u) { if (xb_ld(&bar[XB_TMO])) break; if (sp > XB_SPIN_CAP) { atomicAdd(&bar[XB_TMO], 1u); break; } }
    }
    nloc = mine > 0u ? mine : 1u; nx = cnt > 0u ? cnt : 1u;
}
__device__ __forceinline__ void xcd_barrier(const XcdBarrier& b) {
    asm volatile("s_waitcnt vmcnt(0)" ::: "memory");
    __syncthreads();
    if (threadIdx.x == 0) {
        unsigned* bar = b.bar;
        __builtin_amdgcn_s_waitcnt(0);
        unsigned nloc = b.st[0], nx = b.st[1];
        if (nloc == 0u) { xcd_barrier_complete(bar, b.x, nloc, nx); b.st[0] = nloc; b.st[1] = nx; }
        const unsigned old = xb_add(&bar[XB_XSUB(b.x)], 1u);
        const unsigned gen = old / nloc;
        if (old + 1u == (gen + 1u) * nloc) {
            __builtin_amdgcn_fence(__ATOMIC_RELEASE, "agent");
            asm volatile("s_waitcnt vmcnt(0)" ::: "memory");
            const unsigned og = xb_add(&bar[XB_TOP], 1u);
            const unsigned tg = og / nx;
            if (og + 1u == (tg + 1u) * nx) xb_add(&bar[XB_TOPGEN], 1u);
            else XB_SPIN(xb_ld(&bar[XB_TOPGEN]) == tg, bar);
            __builtin_amdgcn_fence(__ATOMIC_ACQUIRE, "agent");
            xb_add(&bar[XB_XGEN(b.x)], 1u);
            asm volatile("s_waitcnt vmcnt(0)" ::: "memory");
        } else {
            XB_SPIN(xb_ld(&bar[XB_XGEN(b.x)]) == gen, bar);
            __builtin_amdgcn_fence(__ATOMIC_ACQUIRE, "agent");
            asm volatile("s_waitcnt vmcnt(0)" ::: "memory");
        }
    }
    __syncthreads();
}

#ifndef WGM_P1
#define WGM_P1 4
#endif
#ifndef WGM_P4
#define WGM_P4 4
#endif
#ifndef WGM_C
#define WGM_C 4
#endif
constexpr int NWAVES = 8, NTHREADS = 512;
constexpr int LDS_BYTES = 147456;
constexpr size_t MiB = 1u << 20;
constexpr size_t SZ_WIN = (size_t)N_IN * D_MODEL * 2, SZ_WA = (size_t)D_MODEL * W_A * 2, SZ_WB = (size_t)D_MODEL * W_B * 2, SZ_WM = (size_t)D_MODEL * W_M * 2,
                 SZ_WO = (size_t)D_MODEL * D_MODEL * 2, SZ_WMEM = (size_t)(2 * W_M) * D_MODEL * 2;
constexpr size_t SZ_WL = SZ_WIN + SZ_WA + SZ_WB + SZ_WM + SZ_WO + SZ_WMEM;
constexpr size_t WS_SS = 131072;
constexpr size_t WS_CTL = 0, CTL_ZERO_BYTES = 16384;
constexpr size_t WS_W = 1 * MiB;
constexpr int LDS_MISC = 131072, LDS_XL = 131072 + 256;
constexpr size_t WS_MEMN = WS_W + DEPTH * SZ_WL;
constexpr size_t WS_MKV = WS_MEMN + (size_t)DEPTH * MMEM * D_MODEL * 2;
constexpr size_t WS_H = WS_MKV + (size_t)DEPTH * MMEM * (2 * W_M) * 2;
constexpr size_t WS_MERGED = WS_H + (size_t)MTOK * D_MODEL * 2;
constexpr size_t WS_PROJ = WS_MERGED + (size_t)MHALF * D_MODEL * 2;
constexpr size_t WS_GT = WS_PROJ + (size_t)MHALF * PJW * 2;
constexpr size_t WS_Y = WS_GT + (size_t)3 * 64 * 8 * 65536;
constexpr size_t WS_END = WS_Y + (size_t)MHALF * D_MODEL * 2;
constexpr int Y_A = 0, Y_B = 512, Y_M = 1536;
static_assert(WS_END <= (size_t)1024 * MiB, "workspace map must fit 1 GiB");

__device__ __forceinline__ void p0_transpose_item(const float* W, int K, int N, bf16_t* WT, int ldwt, LAS float* scr, int item, int lane) {
    const int nblk = N / 32, kb = item / nblk, nb = item % nblk, k0 = 64 * kb, n0 = 32 * nb;
#pragma unroll 8
    for (int i = 0; i < 32; ++i) { const int kk = 2 * i + (lane >> 5); scr[kk * 33 + (lane & 31)] = W[(size_t)(k0 + kk) * N + n0 + (lane & 31)]; }
    asm volatile("s_waitcnt lgkmcnt(0)" ::: "memory");
    const int c = lane & 7;
#pragma unroll
    for (int j = 0; j < 4; ++j) { const int n = (lane >> 3) + 8 * j; const LAS float* s = scr + (8 * c) * 33 + n;
        u32x4 o; o.x = pk2(s[0 * 33], s[1 * 33]); o.y = pk2(s[2 * 33], s[3 * 33]); o.z = pk2(s[4 * 33], s[5 * 33]); o.w = pk2(s[6 * 33], s[7 * 33]);
        *(u32x4*)(WT + (size_t)(n0 + n) * ldwt + k0 + 8 * c) = o; }
    asm volatile("s_waitcnt lgkmcnt(0)" ::: "memory");
}
__device__ __forceinline__ void rms_row_to_bf16(const float* xrow, const float* g, bf16_t* orow, int lane) {
    const f32x4* xr = (const f32x4*)xrow + lane; const f32x4* gr = (const f32x4*)g + lane;
    f32x4 v[8]; float s = 0.f;
#pragma unroll
    for (int j = 0; j < 8; ++j) { v[j] = xr[64 * j]; s += (v[j].x * v[j].x + v[j].y * v[j].y) + (v[j].z * v[j].z + v[j].w * v[j].w); }
    const float rstd = rsqrtf(wave_sum(s) * (1.f / D_MODEL) + EPS);
    u32x2* o8 = (u32x2*)orow + lane;
#pragma unroll
    for (int j = 0; j < 8; ++j) { const f32x4 gg = gr[64 * j]; u32x2 r; r.x = pk2(v[j].x * rstd * gg.x, v[j].y * rstd * gg.y); r.y = pk2(v[j].z * rstd * gg.z, v[j].w * rstd * gg.w); o8[64 * j] = r; }
}

__device__ __forceinline__ void scale_row_to_bf16(const float* xrow, const float* g, bf16_t* orow, float* ss_out, int lane) {
    const f32x4* xr = (const f32x4*)xrow + lane; const f32x4* gr = (const f32x4*)g + lane;
    f32x4 v[8]; float s = 0.f;
#pragma unroll
    for (int j = 0; j < 8; ++j) { v[j] = xr[64 * j]; s += (v[j].x * v[j].x + v[j].y * v[j].y) + (v[j].z * v[j].z + v[j].w * v[j].w); }
    s = wave_sum(s);
    if (lane == 0) *ss_out = s;
    u32x2* o8 = (u32x2*)orow + lane;
#pragma unroll
    for (int j = 0; j < 8; ++j) { const f32x4 gg = gr[64 * j]; u32x2 r; r.x = pk2(v[j].x * gg.x, v[j].y * gg.y); r.y = pk2(v[j].z * gg.z, v[j].w * gg.w); o8[64 * j] = r; }
}
struct Args { const float* in[17]; float* out; unsigned char* ws; };


#ifdef PROBE_SEL
#define TS_BEGIN(cat) do { if (PROBE_SEL == (cat)) tstart = __builtin_amdgcn_s_memrealtime(); } while (0)
#define TS_END(cat) do { if (PROBE_SEL == (cat)) tacc += __builtin_amdgcn_s_memrealtime() - tstart; } while (0)
#else
#define TS_BEGIN(cat) do {} while (0)
#define TS_END(cat) do {} while (0)
#endif
#ifndef PROBE_DUP
#define PROBE_DUP 0
#endif
constexpr int REP_P1 = (PROBE_DUP == 1) ? 2 : 1, REP_B = (PROBE_DUP == 2) ? 2 : 1, REP_C = (PROBE_DUP == 3) ? 2 : 1, REP_SYNC = (PROBE_DUP == 4) ? 2 : 1, REP_P0 = (PROBE_DUP == 5) ? 2 : 1, REP_P4 = (PROBE_DUP == 6) ? 2 : 1, REP_CA = (PROBE_DUP == 7) ? 2 : 1, REP_MA = (PROBE_DUP == 8) ? 2 : 1, REP_CV = (PROBE_DUP == 9) ? 2 : 1, REP_MA0 = (PROBE_DUP == 10) ? 2 : 1, REP_CA0 = (PROBE_DUP == 11) ? 2 : 1;
#define GSYNC() do { TS_BEGIN(5); for (int rs_ = 0; rs_ < REP_SYNC; ++rs_) xcd_barrier(xbar); TS_END(5); } while (0)
__global__ void __launch_bounds__(NTHREADS, 2) fwd_megakernel(Args args) {
#ifdef PROBE_SEL
    unsigned long long tstart = 0, tacc = 0;
#endif
    extern __shared__ __attribute__((aligned(16))) unsigned char lds_raw[];
    LAS unsigned char* lds = (LAS unsigned char*)lds_raw;
    cg::grid_group grid = cg::this_grid();
    const int tid = threadIdx.x, lane = tid & 63, wave = __builtin_amdgcn_readfirstlane(tid >> 6);
    const int G = gridDim.x, bx = blockIdx.x;
    const int gw = bx * NWAVES + wave, NGW = G * NWAVES;
    const int vcu = (G % 8 == 0) ? (bx % 8) * (G / 8) + bx / 8 : bx;
    unsigned char* ws = args.ws;
    if (tid < 2) ((volatile LAS unsigned*)(lds + LDS_MISC))[tid] = 0u;
    __syncthreads();
    const XcdBarrier xbar = xcd_barrier_post((unsigned*)(ws + WS_CTL), (volatile LAS unsigned*)(lds + LDS_MISC));
    float* out = args.out;
    bf16_t* Hb = (bf16_t*)(ws + WS_H); bf16_t* MERGED = (bf16_t*)(ws + WS_MERGED); bf16_t* PROJ = (bf16_t*)(ws + WS_PROJ); bf16_t* YB = (bf16_t*)(ws + WS_Y); bf16_t* GT = (bf16_t*)(ws + WS_GT); float* SSQ = (float*)(ws + WS_SS);
    bf16_t* MEMN = (bf16_t*)(ws + WS_MEMN); bf16_t* MKV = (bf16_t*)(ws + WS_MKV);
#define WT_IN(l)  ((bf16_t*)(ws + WS_W + (size_t)(l) * SZ_WL))
#define WT_A(l)   ((bf16_t*)(ws + WS_W + (size_t)(l) * SZ_WL + SZ_WIN))
#define WT_B(l)   ((bf16_t*)(ws + WS_W + (size_t)(l) * SZ_WL + SZ_WIN + SZ_WA))
#define WT_M(l)   ((bf16_t*)(ws + WS_W + (size_t)(l) * SZ_WL + SZ_WIN + SZ_WA + SZ_WB))
#define WT_O(l)   ((bf16_t*)(ws + WS_W + (size_t)(l) * SZ_WL + SZ_WIN + SZ_WA + SZ_WB + SZ_WM))
#define WT_MEM(l) ((bf16_t*)(ws + WS_W + (size_t)(l) * SZ_WL + SZ_WIN + SZ_WA + SZ_WB + SZ_WM + SZ_WO))

#define PJB(col) (PROJ + (size_t)((col) >> 7) * MHALF * 128)
    TS_BEGIN(0);
    for (int rep = 0; rep < REP_P0; ++rep) {
        LAS float* scr = (LAS float*)(lds + wave * 16384);
        constexpr int I_IN = (D_MODEL / 64) * (N_IN / 32), I_A = (W_A / 64) * (D_MODEL / 32), I_B = (W_B / 64) * (D_MODEL / 32), I_M = (W_M / 64) * (D_MODEL / 32),
                      I_O = (D_MODEL / 64) * (D_MODEL / 32), I_MEM = (D_MODEL / 64) * (2 * W_M / 32);
        constexpr int I_L = I_IN + I_A + I_B + I_M + I_O + I_MEM;
        for (int it = gw; it < DEPTH * I_L; it += NGW) {
            const int l = it / I_L; int r = it % I_L;
            if (r < I_IN) { p0_transpose_item(args.in[3] + (size_t)l * D_MODEL * N_IN, D_MODEL, N_IN, WT_IN(l), D_MODEL, scr, r, lane); continue; } r -= I_IN;
            if (r < I_A) { p0_transpose_item(args.in[13] + (size_t)l * W_A * D_MODEL, W_A, D_MODEL, WT_A(l) + Y_A, D_MODEL, scr, r, lane); continue; } r -= I_A;
            if (r < I_B) { p0_transpose_item(args.in[14] + (size_t)l * W_B * D_MODEL, W_B, D_MODEL, WT_A(l) + Y_B, D_MODEL, scr, r, lane); continue; } r -= I_B;
            if (r < I_M) { p0_transpose_item(args.in[15] + (size_t)l * W_M * D_MODEL, W_M, D_MODEL, WT_A(l) + Y_M, D_MODEL, scr, r, lane); continue; } r -= I_M;
            if (r < I_O) { p0_transpose_item(args.in[16] + (size_t)l * D_MODEL * D_MODEL, D_MODEL, D_MODEL, WT_O(l), D_MODEL, scr, r, lane); continue; } r -= I_O;
            p0_transpose_item(args.in[10] + (size_t)l * D_MODEL * (2 * W_M), D_MODEL, 2 * W_M, WT_MEM(l), D_MODEL, scr, r, lane);
        }
        for (int m = gw; m < DEPTH * MMEM; m += NGW) { const int l = m / MMEM, r = m % MMEM;
            rms_row_to_bf16(args.in[1] + (size_t)r * D_MODEL, args.in[9] + (size_t)l * D_MODEL, MEMN + (size_t)m * D_MODEL, lane); }
        for (int m = gw; m < MTOK; m += NGW) { scale_row_to_bf16(args.in[0] + (size_t)m * D_MODEL, args.in[2], Hb + (size_t)m * D_MODEL, SSQ + m, lane); if (lane == 0) SSQ[MTOK + m] = 0.f; }
    }
    TS_END(0);
    if (args.ws == nullptr) grid.sync();
    GSYNC();

    for (int it = 0; it <= 4; ++it) {
        const int l = (it >> 1) & 1, half = it & 1;
        TS_BEGIN(1);
        if (it == 0) {
            for (int ll = 0; ll < DEPTH; ++ll) {
                pg8::Gemm g{MEMN + (size_t)ll * MMEM * D_MODEL, WT_MEM(ll), MMEM, 2 * W_M, D_MODEL, D_MODEL, D_MODEL};
                pg8::StaticOrder S; S.init(MMEM, 2 * W_M, G, (bx + 32 * ll) % G);
                pg8::EpiBf16 E{MKV + (size_t)ll * MMEM * (2 * W_M), 2 * W_M};
                pg8::gemm_phase<pg8::EpiBf16>(lds, g, S, E);
            }
        }
        if (it >= 1) {
            const int pl = ((it - 1) >> 1) & 1, ph = (it - 1) & 1;
            pg8::Gemm g{MERGED, WT_O(pl), MHALF, D_MODEL, D_MODEL, D_MODEL, D_MODEL};
            pg8::StaticOrder S; S.init(MHALF, D_MODEL, G, bx, WGM_P4);
            pg8::EpiResid E{args.in[0] + (size_t)ph * MHALF * D_MODEL, out + (size_t)ph * MHALF * D_MODEL, Hb + (size_t)ph * MHALF * D_MODEL, args.in[2] + D_MODEL, SSQ + MTOK + (size_t)ph * MHALF, pl == 0 ? 1 : 0};
            for (int rep = 0; rep < (pl == 0 ? REP_P4 : 1); ++rep) pg8::gemm_phase<pg8::EpiResid>(lds, g, S, E);
        }
        TS_END(1);
        if (it == 4) break;
        TS_BEGIN(2);
        for (int rep = 0; rep < REP_P1; ++rep) {
            pg8::Gemm g{Hb + (size_t)half * MHALF * D_MODEL, WT_IN(l), MHALF, N_IN, D_MODEL, D_MODEL, D_MODEL};
            pg8::StaticOrder S; S.init(MHALF, N_IN, G, bx, WGM_P1);
            pg8::EpiProj E{PROJ, PJW, args.in[4] + (size_t)l * 3 * D_MODEL, GT, SSQ + (size_t)l * MTOK + (size_t)half * MHALF, args.in[7] + (size_t)l * HEAD_DIM, (LAS float*)(lds + LDS_XL)};
            pg8::gemm_phase<pg8::EpiProj>(lds, g, S, E);
        }
        TS_END(2);
        GSYNC();
        TS_BEGIN(3);
        for (int rep = 0; rep < REP_B; ++rep) {
            for (int rp = 0; rp < REP_CA * REP_CA0; ++rp)
            for (int u = vcu; u < 4 * H_B * 16; u += G) {
                const int qb = u & 15, hd = (u >> 4) & 7, bb = u >> 7;
                const int n0 = 4 * qb, jstart = (8 - n0) > 0 ? (8 - n0) : 0;
                at::attn_unit<true, false>(lds, PJB(C_Q + hd * HEAD_DIM), PJB(C_BZ + hd * HEAD_DIM), HEAD_DIM, YB + Y_B + hd * HEAD_DIM, D_MODEL, PJB(C_K + hd * HEAD_DIM), PJB(C_V + hd * HEAD_DIM), HEAD_DIM,
                                    bb * SEQ + qb * 256, bb * SEQ + (n0 - 8) * CHUNK, jstart, (REP_CA0 == 2 && rp == 0) ? jstart : 12,
                                    args.in[6] + (size_t)l * HEAD_DIM, args.in[7] + (size_t)l * HEAD_DIM, args.in[8] + (size_t)l * 513 * H_B + hd);
            }
            for (int rp = 0; rp < REP_MA * REP_MA0; ++rp)
            for (int u = vcu; u < 4 * H_M * 16; u += G) {
                const int qb = u & 15, hd = (u >> 4) & 3, bb = u >> 6;
                const bf16_t* kv = MKV + (size_t)l * MMEM * (2 * W_M) + hd * HEAD_DIM;
                at::attn_unit<false, true>(lds, PJB(C_MQ + hd * HEAD_DIM), PJB(C_MZ + hd * HEAD_DIM), HEAD_DIM, YB + Y_M + hd * HEAD_DIM, D_MODEL, kv, kv + W_M, 2 * W_M,
                                     bb * SEQ + qb * 256, (half * 4 + bb) * MEM_LEN, 0, (REP_MA0 == 2 && rp == 0) ? 0 : 4,
                                     args.in[11] + (size_t)l * HEAD_DIM, args.in[12] + (size_t)l * HEAD_DIM, args.in[8]);
            }
            {
                int lane_ = threadIdx.x & 63; asm volatile("" : "+v"(lane_)); const int lane = lane_;
                const float* cw = args.in[5] + (size_t)l * 3 * W_A + 8 * lane;
                f32x4 wv[3][2];
#pragma unroll
                for (int tp = 0; tp < 3; ++tp) { wv[tp][0] = *(const f32x4*)(cw + tp * W_A); wv[tp][1] = *(const f32x4*)(cw + tp * W_A + 4); }
                const int rpw = (MHALF + NGW - 1) / NGW, rbeg = (vcu * NWAVES + wave) * rpw, rend = (rbeg + rpw) < MHALF ? (rbeg + rpw) : MHALF;
                for (int rp = 0; rp < REP_CV; ++rp)
                for (int r = rbeg; r < rend; ++r) {
                    const int t = r & (SEQ - 1);
                    const bf16_t* base = PROJ + ((size_t)(lane >> 4) * MHALF + r) * 128 + 8 * (lane & 15);
                    const u32x4 ab = *(const u32x4*)(base + (size_t)C_AB * MHALF), az = *(const u32x4*)(base + (size_t)C_AZ * MHALF);
                    float acc[8];
#pragma unroll
                    for (int k = 0; k < 8; ++k) acc[k] = 0.f;
#pragma unroll
                    for (int tp = 0; tp < 3; ++tp) {
                        const int dt = 2 - tp;
                        if (t >= dt) {
                            const bf16_t* pb = base - (size_t)dt * 128;
                            const u32x4 ac = *(const u32x4*)(pb + (size_t)C_AC * MHALF), ax = *(const u32x4*)(pb + (size_t)C_AX * MHALF);
#pragma unroll
                            for (int k = 0; k < 4; ++k) { acc[2 * k] += wv[tp][k >> 1][(2 * k) & 3] * bflo(ac[k]) * bflo(ax[k]); acc[2 * k + 1] += wv[tp][k >> 1][(2 * k + 1) & 3] * bfhi(ac[k]) * bfhi(ax[k]); }
                        }
                    }
                    u32x4 o;
#pragma unroll
                    for (int k = 0; k < 4; ++k) o[k] = pk2(bflo(ab[k]) * acc[2 * k] * bflo(az[k]), bfhi(ab[k]) * acc[2 * k + 1] * bfhi(az[k]));
                    *(u32x4*)(YB + (size_t)r * D_MODEL + Y_A + 8 * lane) = o;
                }
            }
        }
        TS_END(3);
        GSYNC();
        TS_BEGIN(4);
        for (int rep = 0; rep < REP_C; ++rep) {
            pg8::StaticOrder S; S.init(MHALF, D_MODEL, G, bx, WGM_C);
            pg8::Gemm g{YB, WT_A(l), MHALF, D_MODEL, D_MODEL, D_MODEL, D_MODEL};
            pg8::EpiGateFinal E{GT, MERGED};
            pg8::HookGate HK{GT};
            pg8::gemm_phase<pg8::EpiGateFinal, pg8::HookGate>(lds, g, S, E, HK);
        }
        TS_END(4);
        GSYNC();
    }
#ifdef PROBE_SEL
    grid.sync();
    if (bx == 0 && tid == 0) out[0] = (float)tacc * 0.01f;
#endif
}

extern "C" void kernel_launch(void* const* d_in, const int* in_sizes, int n_in, void* d_out, int out_size, void* d_ws, size_t ws_size, hipStream_t stream) {
    static int grid_blocks = 0;
    if (grid_blocks == 0) {
        if (n_in != 17 || in_sizes[0] != MTOK * D_MODEL || out_size != MTOK * D_MODEL || ws_size < WS_END) {
            fprintf(stderr, "kernel_launch: unexpected shapes (n_in %d, in0 %d, out %d, ws %zu < %zu); nothing launched\n", n_in, n_in > 0 ? in_sizes[0] : -1, out_size, ws_size, (size_t)WS_END);
            grid_blocks = -1; return; }
        int dev = 0, cus = 0, per_cu = 0;
        hipGetDevice(&dev);
        hipDeviceGetAttribute(&cus, hipDeviceAttributeMultiprocessorCount, dev);
        hipFuncSetAttribute((const void*)fwd_megakernel, hipFuncAttributeMaxDynamicSharedMemorySize, LDS_BYTES);
        hipOccupancyMaxActiveBlocksPerMultiprocessor(&per_cu, (const void*)fwd_megakernel, NTHREADS, LDS_BYTES);
        if (per_cu < 1) per_cu = 1;
        grid_blocks = cus * per_cu;
        (void)hipGetLastError();
    }
    if (grid_blocks < 0) return;
    if (hipMemsetAsync((char*)d_ws + WS_CTL, 0, CTL_ZERO_BYTES, stream) != hipSuccess) { fprintf(stderr, "kernel_launch: memset of barrier words failed\n"); return; }
    Args a{};
    for (int i = 0; i < 17; ++i) a.in[i] = (const float*)d_in[i];
    a.out = (float*)d_out; a.ws = (unsigned char*)d_ws;
    void* kargs[] = {&a};
    hipError_t e = hipLaunchCooperativeKernel((const void*)fwd_megakernel, dim3(grid_blocks), dim3(NTHREADS), kargs, LDS_BYTES, stream);
    if (e != hipSuccess) fprintf(stderr, "cooperative launch failed: %s (grid %d)\n", hipGetErrorString(e), grid_blocks);
}
```

```cpp
#include <hip/hip_runtime.h>
#include <hip/hip_cooperative_groups.h>
#include <cstdio>
#include <cstdint>
namespace cg = cooperative_groups;

#define LAS __attribute__((address_space(3)))
typedef unsigned short bf16_t;
typedef short bf16x8 __attribute__((ext_vector_type(8)));
typedef short s16x4 __attribute__((ext_vector_type(4)));
typedef float f32x4 __attribute__((ext_vector_type(4)));
typedef float f32x16 __attribute__((ext_vector_type(16)));
typedef unsigned u32x4 __attribute__((ext_vector_type(4)));
typedef unsigned u32x2 __attribute__((ext_vector_type(2)));
typedef float f32x2_t __attribute__((ext_vector_type(2)));
typedef __bf16 bf16x2_t __attribute__((ext_vector_type(2)));

constexpr int D_MODEL = 2048, BATCH = 8, SEQ = 4096, DEPTH = 2, CHUNK = 64, MEM_LEN = 256, HEAD_DIM = 128;
constexpr int W_A = 512, W_B = 1024, W_M = 512, H_B = 8, H_M = 4, N_IN = 13312;
constexpr int MTOK = BATCH * SEQ;
constexpr int MHALF = MTOK / 2;
constexpr int MMEM = BATCH * MEM_LEN;
constexpr float EPS = 1e-6f;
constexpr float LOG2E = 1.4426950408889634f;
constexpr int PJW = 7168;
constexpr int C_AB = 0, C_AC = 512, C_AX = 1024, C_AZ = 1536, C_Q = 2048, C_K = 3072, C_V = 4096, C_BZ = 5120, C_MQ = 6144, C_MZ = 6656, C_GA = 7168, C_GB = 9216, C_GM = 11264;

__device__ __forceinline__ unsigned pk2(float lo, float hi) { f32x2_t v = {lo, hi}; bf16x2_t b = __builtin_convertvector(v, bf16x2_t); return __builtin_bit_cast(unsigned, b); }
__device__ __forceinline__ float bflo(unsigned w) { return __uint_as_float(w << 16); }
__device__ __forceinline__ float bfhi(unsigned w) { return __uint_as_float(w & 0xffff0000u); }
__device__ __forceinline__ float sigmoidf_(float v) { return __builtin_amdgcn_rcpf(1.0f + __builtin_amdgcn_exp2f(-v * LOG2E)); }
__device__ __forceinline__ float row16_sum(float v) {
    v += __uint_as_float(__builtin_amdgcn_update_dpp(0u, __float_as_uint(v), 0xB1, 0xF, 0xF, true));
    v += __uint_as_float(__builtin_amdgcn_update_dpp(0u, __float_as_uint(v), 0x4E, 0xF, 0xF, true));
    v += __uint_as_float(__builtin_amdgcn_update_dpp(0u, __float_as_uint(v), 0x124, 0xF, 0xF, true));
    v += __uint_as_float(__builtin_amdgcn_update_dpp(0u, __float_as_uint(v), 0x128, 0xF, 0xF, true));
    return v;
}
__device__ __forceinline__ float half_sum(float v) { auto rr = __builtin_amdgcn_permlane32_swap(__float_as_uint(v), __float_as_uint(v), false, false); return __uint_as_float(rr[0]) + __uint_as_float(rr[1]); }
__device__ __forceinline__ float half_max(float v) { auto rr = __builtin_amdgcn_permlane32_swap(__float_as_uint(v), __float_as_uint(v), false, false); return fmaxf(__uint_as_float(rr[0]), __uint_as_float(rr[1])); }
__device__ __forceinline__ float wave_sum(float v) {
#pragma unroll
    for (int o = 1; o < 64; o <<= 1) v += __shfl_xor(v, o);
    return v;
}

namespace pg8 {
constexpr int BM = 256, BK = 64, HALF = 128, HTB = HALF * BK * 2, STAGE_BYTES = 8 * HTB, NXCD = 8, WGM = 8;
__host__ __device__ __forceinline__ int lds_byte(int r, int c) { const int st = (r >> 4) * 2 + (c >> 5), rr = r & 15, cc = c & 31, ob = rr * 64 + cc * 2; return st * 1024 + (ob ^ (((ob >> 9) & 1) << 5)); }
__host__ __device__ __forceinline__ void stage_rc(int b, int& R, int& C) { const int st = b / 1024, sb = b % 1024, swz = sb ^ (((sb >> 9) & 1) << 5); R = (st >> 1) * 16 + swz / 64; C = (st & 1) * 32 + (swz % 64) / 2; }
__host__ __device__ __forceinline__ int perm32(int rho) { const int n = rho >> 4, i = rho & 15; return 8 * (i >> 2) + 4 * n + (i & 3); }

struct Unit { int pm, pn; };
__device__ __forceinline__ unsigned gt_off(int br, int pm, int pn, int wid, int lane) { return (unsigned)(((br * 64 + pm) * 8 + pn) * 65536 + wid * 8192 + lane * 8); }
__device__ __forceinline__ float ub(unsigned w, int k) { return (float)((w >> (8 * k)) & 0xffu); }
struct Gemm { const bf16_t* A; const bf16_t* Bt; int M, N, K, lda, ldb; };

struct StaticOrder {
    int nM, nN, nwg, G, c, wgm;
    __device__ void init(int M, int N, int G_, int c_, int wgm_ = WGM) { nM = M / BM; nN = N / BM; nwg = nM * nN; G = G_; c = c_; wgm = wgm_; }
    __device__ bool next(int i, Unit& u) const {
        const long L = (long)i * G + c; if (L >= nwg) return false;
        int wgid = (int)L; { const int q = nwg / NXCD, r = nwg % NXCD, xcd = wgid % NXCD, off = wgid / NXCD; wgid = (xcd < r ? xcd * (q + 1) : r * (q + 1) + (xcd - r) * q) + off; }
        const int nig = wgm * nN, gid = wgid / nig, fm = gid * wgm, gsz = (nM - fm) < wgm ? (nM - fm) : wgm;
        u.pm = fm + ((wgid % nig) % gsz); u.pn = (wgid % nig) / gsz; return true;
    }
};

struct EpiBf16 {
    static constexpr bool PERM = true;
    bf16_t* O; int ldc;
    __device__ __forceinline__ void operator()(const f32x4 (&acc)[2][2][4][2], const Unit& u, int wr, int wc, int fr, int fq) const {
        const int row0 = u.pm * BM + wr * 64 + fr, col0 = u.pn * BM + wc * 32 + 8 * fq;
#pragma unroll
        for (int ai = 0; ai < 2; ++ai)
#pragma unroll
            for (int m = 0; m < 4; ++m) { bf16_t* rowp = O + (size_t)(row0 + ai * HALF + m * 16) * ldc + col0;
#pragma unroll
                for (int bj = 0; bj < 2; ++bj) { const f32x4 v0 = acc[ai][bj][m][0], v1 = acc[ai][bj][m][1];
                    u32x4 w; w.x = pk2(v0[0], v0[1]); w.y = pk2(v0[2], v0[3]); w.z = pk2(v1[0], v1[1]); w.w = pk2(v1[2], v1[3]);
                    *(u32x4*)(rowp + bj * HALF) = w; } }
    }
};
struct EpiProj {
    static constexpr bool PERM = true;
    bf16_t* O; int ldc; const float* bgate; bf16_t* GT; const float* ssq;
    const float* gk; LAS float* xl;
    __device__ __forceinline__ void operator()(const f32x4 (&acc)[2][2][4][2], const Unit& u, int wr, int wc, int fr, int fq) const {
        const int colt = u.pn * BM;
        int mode = 0;
        if (colt >= C_GA) mode = 2; else if ((colt >= C_AZ && colt < C_Q) || (colt >= C_BZ && colt < C_MQ) || (colt >= C_MZ)) mode = 1;
        const bool knorm = (colt >= C_K && colt < C_V);
        const int row0 = u.pm * BM + wr * 64 + fr, col0 = colt + wc * 32 + 8 * fq;
        f32x4 bv[2][2];
#pragma unroll
        for (int bj = 0; bj < 2; ++bj)
#pragma unroll
            for (int n = 0; n < 2; ++n) bv[bj][n] = (mode == 2) ? *(const f32x4*)(bgate + (col0 - C_GA) + bj * HALF + 4 * n) : (f32x4){0.f, 0.f, 0.f, 0.f};
        float rk[2][4][2];
        f32x4 gkv[2];
        if (knorm) {
            gkv[0] = *(const f32x4*)(gk + wc * 32 + 8 * fq); gkv[1] = *(const f32x4*)(gk + wc * 32 + 8 * fq + 4);
#pragma unroll
            for (int ai = 0; ai < 2; ++ai)
#pragma unroll
                for (int m = 0; m < 4; ++m) { const float rstd = rsqrtf(ssq[row0 + ai * HALF + m * 16] * (1.0f / D_MODEL) + EPS);
#pragma unroll
                    for (int bj = 0; bj < 2; ++bj) { const f32x4 v0 = acc[ai][bj][m][0] * rstd, v1 = acc[ai][bj][m][1] * rstd;
                        float sq = (v0[0] * v0[0] + v0[1] * v0[1]) + (v0[2] * v0[2] + v0[3] * v0[3]) + (v1[0] * v1[0] + v1[1] * v1[1]) + (v1[2] * v1[2] + v1[3] * v1[3]);
                        sq += __shfl_xor(sq, 16); sq += __shfl_xor(sq, 32);
                        if (fq == 0) xl[((ai * HALF + wr * 64 + m * 16 + fr) * 2 + bj) * 4 + wc] = sq; } }
            asm volatile("s_waitcnt lgkmcnt(0)\n\ts_barrier" ::: "memory");
#pragma unroll
            for (int ai = 0; ai < 2; ++ai)
#pragma unroll
                for (int m = 0; m < 4; ++m)
#pragma unroll
                    for (int bj = 0; bj < 2; ++bj) { const f32x4 t = *(const LAS f32x4*)(xl + ((ai * HALF + wr * 64 + m * 16 + fr) * 2 + bj) * 4);
                        rk[ai][m][bj] = rsqrtf(((t[0] + t[1]) + (t[2] + t[3])) * (1.0f / HEAD_DIM) + EPS); }
        }
#pragma unroll
        for (int ai = 0; ai < 2; ++ai)
#pragma unroll
            for (int m = 0; m < 4; ++m) { bf16_t* rowp = O + ((size_t)(colt >> 7) * MHALF + (row0 + ai * HALF + m * 16)) * 128 + wc * 32 + 8 * fq;
                const float rstd = rsqrtf(ssq[row0 + ai * HALF + m * 16] * (1.0f / D_MODEL) + EPS);
#pragma unroll
                for (int bj = 0; bj < 2; ++bj) { f32x4 v0 = acc[ai][bj][m][0] * rstd + bv[bj][0], v1 = acc[ai][bj][m][1] * rstd + bv[bj][1];
                    if (mode != 0) {
                        const float nr = -LOG2E * rstd;
#pragma unroll
                        for (int e = 0; e < 4; ++e) {
                            const float s0 = __builtin_amdgcn_rcpf(1.0f + __builtin_amdgcn_exp2f(__builtin_fmaf(acc[ai][bj][m][0][e], nr, -LOG2E * bv[bj][0][e])));
                            const float s1 = __builtin_amdgcn_rcpf(1.0f + __builtin_amdgcn_exp2f(__builtin_fmaf(acc[ai][bj][m][1][e], nr, -LOG2E * bv[bj][1][e])));
                            v0[e] = (mode == 1) ? v0[e] * s0 : s0; v1[e] = (mode == 1) ? v1[e] * s1 : s1; }
                    }
                    if (knorm) { v0 = v0 * rk[ai][m][bj] * gkv[0]; v1 = v1 * rk[ai][m][bj] * gkv[1]; }
                    if (mode == 2) { u32x2 q; q.x = 0u; q.y = 0u;
#pragma unroll
                        for (int e = 0; e < 4; ++e) { q.x = __builtin_amdgcn_cvt_pk_u8_f32(fmaxf(__builtin_rintf(v0[e] * 255.0f), 1.0f), e, q.x); q.y = __builtin_amdgcn_cvt_pk_u8_f32(fmaxf(__builtin_rintf(v1[e] * 255.0f), 1.0f), e, q.y); }
                        *(u32x2*)((char*)GT + gt_off((colt - C_GA) >> 11, u.pm, ((colt - C_GA) & 2047) >> 8, wr * 4 + wc, fq * 16 + fr) + (unsigned)(((ai * 4 + m) * 2 + bj) * 512)) = q; }
                    else { u32x4 w; w.x = pk2(v0[0], v0[1]); w.y = pk2(v0[2], v0[3]); w.z = pk2(v1[0], v1[1]); w.w = pk2(v1[2], v1[3]);
                        *(u32x4*)(rowp + (size_t)bj * MHALF * 128) = w; } } }
    }
};
struct NoHook { static constexpr bool ON = false; __device__ __forceinline__ void operator()(f32x4 (&)[2][2][4][2], const Unit&, int, int, int, int, int) const {} };
struct HookGate {
    static constexpr bool ON = true;
    const bf16_t* GT;
    __device__ __forceinline__ void operator()(f32x4 (&acc)[2][2][4][2], const Unit& u, int t, int wr, int wc, int fr, int fq) const {
        if (t != W_A / BK && t != (W_A + W_B) / BK) return;
        const int b1 = (t == W_A / BK) ? 0 : 1;
        unsigned o1 = gt_off(b1, u.pm, u.pn, wr * 4 + wc, fq * 16 + fr); asm volatile("" : "+v"(o1));
        const unsigned o2 = o1 + 64u * 8u * 65536u;
        u32x2 g1[2][4][2], g2[2][4][2];
#pragma unroll
        for (int ai = 0; ai < 2; ++ai)
#pragma unroll
            for (int m = 0; m < 4; ++m)
#pragma unroll
                for (int bj = 0; bj < 2; ++bj) { const unsigned off = (unsigned)(((ai * 4 + m) * 2 + bj) * 512);
                    g1[ai][m][bj] = *(const u32x2*)((const char*)GT + o1 + off); g2[ai][m][bj] = *(const u32x2*)((const char*)GT + o2 + off); }
#pragma unroll
        for (int ai = 0; ai < 2; ++ai)
#pragma unroll
            for (int m = 0; m < 4; ++m)
#pragma unroll
                for (int bj = 0; bj < 2; ++bj)
#pragma unroll
                    for (int n = 0; n < 2; ++n)
#pragma unroll
                        for (int e = 0; e < 4; ++e) acc[ai][bj][m][n][e] *= ub(g1[ai][m][bj][n], e) * __builtin_amdgcn_rcpf(ub(g2[ai][m][bj][n], e));
        asm volatile("" ::: "memory");
    }
};
struct EpiGateFinal {
    static constexpr bool PERM = true;
    const bf16_t* GT; bf16_t* MG;
    __device__ __forceinline__ void operator()(const f32x4 (&acc)[2][2][4][2], const Unit& u, int wr, int wc, int fr, int fq) const {
        const int row0 = u.pm * BM + wr * 64 + fr, col0 = u.pn * BM + wc * 32 + 8 * fq;
        const unsigned ob = (unsigned)(row0 * D_MODEL + col0) * 2u, og = gt_off(2, u.pm, u.pn, wr * 4 + wc, fq * 16 + fr);
        u32x2 gg[2][4][2];
#pragma unroll
        for (int ai = 0; ai < 2; ++ai)
#pragma unroll
            for (int m = 0; m < 4; ++m)
#pragma unroll
                for (int bj = 0; bj < 2; ++bj) gg[ai][m][bj] = *(const u32x2*)((const char*)GT + og + (unsigned)(((ai * 4 + m) * 2 + bj) * 512));
        constexpr float S = 1.0f / 255.0f;
#pragma unroll
        for (int ai = 0; ai < 2; ++ai)
#pragma unroll
            for (int m = 0; m < 4; ++m)
#pragma unroll
                for (int bj = 0; bj < 2; ++bj) { const u32x2 g = gg[ai][m][bj];
                    const f32x4 a0 = acc[ai][bj][m][0] * S, a1 = acc[ai][bj][m][1] * S;
                    u32x4 w; w.x = pk2(ub(g.x, 0) * a0[0], ub(g.x, 1) * a0[1]); w.y = pk2(ub(g.x, 2) * a0[2], ub(g.x, 3) * a0[3]);
                    w.z = pk2(ub(g.y, 0) * a1[0], ub(g.y, 1) * a1[1]); w.w = pk2(ub(g.y, 2) * a1[2], ub(g.y, 3) * a1[3]);
                    *(u32x4*)((char*)MG + ob + (unsigned)((ai * HALF + m * 16) * D_MODEL + bj * HALF) * 2u) = w; }
    }
};
struct EpiResid {
    static constexpr bool PERM = true;
    const float* base; float* out; bf16_t* hbuf; const float* gnext; float* ssq; int first;
    __device__ __forceinline__ void operator()(const f32x4 (&acc)[2][2][4][2], const Unit& u, int wr, int wc, int fr, int fq) const {
        const int row0 = u.pm * BM + wr * 64 + fr, col0 = u.pn * BM + wc * 32 + 8 * fq;
        const unsigned ob = (unsigned)(row0 * D_MODEL + col0) * 4u;
        const bool hx = (first != 0);
        f32x4 gv[2][2];
#pragma unroll
        for (int bj = 0; bj < 2; ++bj)
#pragma unroll
            for (int n = 0; n < 2; ++n) { gv[bj][n] = *(const f32x4*)(gnext + col0 + bj * HALF + 4 * n);
                if (!hx) { gv[bj][n][0] = 1.0f / gv[bj][n][0]; gv[bj][n][1] = 1.0f / gv[bj][n][1]; gv[bj][n][2] = 1.0f / gv[bj][n][2]; gv[bj][n][3] = 1.0f / gv[bj][n][3]; } }
#pragma unroll
        for (int ai = 0; ai < 2; ++ai) {
            f32x4 bb[4][2][2];
            if (hx) {
#pragma unroll
                for (int mm = 0; mm < 4; ++mm)
#pragma unroll
                    for (int bj = 0; bj < 2; ++bj)
#pragma unroll
                        for (int n = 0; n < 2; ++n) bb[mm][bj][n] = *(const f32x4*)((const char*)base + ob + (unsigned)((ai * HALF + mm * 16) * D_MODEL + bj * HALF + n * 4) * 4u);
            } else {
                u32x4 hw[4][2];
#pragma unroll
                for (int mm = 0; mm < 4; ++mm)
#pragma unroll
                    for (int bj = 0; bj < 2; ++bj) hw[mm][bj] = *(const u32x4*)((const char*)hbuf + (ob >> 1) + (unsigned)((ai * HALF + mm * 16) * D_MODEL + bj * HALF) * 2u);
#pragma unroll
                for (int mm = 0; mm < 4; ++mm)
#pragma unroll
                    for (int bj = 0; bj < 2; ++bj) { const u32x4 h = hw[mm][bj];
                        bb[mm][bj][0] = (f32x4){bflo(h.x) * gv[bj][0][0], bfhi(h.x) * gv[bj][0][1], bflo(h.y) * gv[bj][0][2], bfhi(h.y) * gv[bj][0][3]};
                        bb[mm][bj][1] = (f32x4){bflo(h.z) * gv[bj][1][0], bfhi(h.z) * gv[bj][1][1], bflo(h.w) * gv[bj][1][2], bfhi(h.w) * gv[bj][1][3]}; }
            }
#pragma unroll
            for (int mm = 0; mm < 4; ++mm) {
                float sq = 0.f;
#pragma unroll
                for (int bj = 0; bj < 2; ++bj) {
                    const f32x4 x0 = bb[mm][bj][0] + acc[ai][bj][mm][0], x1 = bb[mm][bj][1] + acc[ai][bj][mm][1];
                    const unsigned eo = (unsigned)((ai * HALF + mm * 16) * D_MODEL + bj * HALF);
                    if (hx) {
                        sq += (x0[0] * x0[0] + x0[1] * x0[1]) + (x0[2] * x0[2] + x0[3] * x0[3]) + (x1[0] * x1[0] + x1[1] * x1[1]) + (x1[2] * x1[2] + x1[3] * x1[3]);
                        u32x4 w; w.x = pk2(x0[0] * gv[bj][0][0], x0[1] * gv[bj][0][1]); w.y = pk2(x0[2] * gv[bj][0][2], x0[3] * gv[bj][0][3]);
                        w.z = pk2(x1[0] * gv[bj][1][0], x1[1] * gv[bj][1][1]); w.w = pk2(x1[2] * gv[bj][1][2], x1[3] * gv[bj][1][3]);
                        *(u32x4*)((char*)hbuf + (ob >> 1) + eo * 2u) = w;
                    } else {
                        *(f32x4*)((char*)out + ob + eo * 4u) = x0; *(f32x4*)((char*)out + ob + eo * 4u + 16u) = x1;
                    }
                }
                if (hx) { sq += __shfl_xor(sq, 16); sq += __shfl_xor(sq, 32);
                    if (fq == 0) atomicAdd(ssq + row0 + ai * HALF + mm * 16, sq); }
            }
            asm volatile("" ::: "memory"); }
    }
};

template <class Epi, class Hook = NoHook>
__device__ __forceinline__ void gemm_phase(LAS unsigned char* lds, const Gemm g, const StaticOrder& S, const Epi& E, const Hook& HK = Hook()) {
    int tid_ = threadIdx.x; asm volatile("" : "+v"(tid_));
    const int tid = tid_, wid = __builtin_amdgcn_readfirstlane(tid >> 6), lane = tid & 63, wr = wid >> 2, wc = wid & 3, fr = lane & 15, fq = lane >> 4;
    const int K = g.K, nt = K / BK;
    unsigned voffA[2], voffB[2];
#pragma unroll
    for (int i = 0; i < 2; ++i) { int R, C; stage_rc(tid * 16 + i * 8192, R, C); const int Rb = Epi::PERM ? ((R & ~31) + perm32(R & 31)) : R;
        voffA[i] = (unsigned)(R * g.lda + C) * 2u; voffB[i] = (unsigned)(Rb * g.ldb + C) * 2u; }
    const size_t kstep = (size_t)(BK * 2);
    const size_t hA = (size_t)HALF * g.lda * 2, hB = (size_t)HALF * g.ldb * 2;
    const size_t tA = 2 * hA, tB = 2 * hB;
    const unsigned ldsw = (unsigned)wid * 1024u;
    const int aoff = lds_byte(wr * 64 + fr, fq * 8), boff = lds_byte(wc * 32 + fr, fq * 8);
#define PG8_SA(b, h) (((b) * 2 + (h)) * HTB)
#define PG8_SB(b, h) ((4 + (b) * 2 + (h)) * HTB)
#define PG8_STAGE(bufoff, gbase, voff) do { _Pragma("unroll") for (int _i = 0; _i < 2; ++_i) \
        __builtin_amdgcn_global_load_lds((const unsigned*)((const char*)(gbase) + (voff)[_i]), (LAS unsigned*)(lds + (bufoff) + ldsw + _i * 8192), 16, 0, 0); } while (0)
#define PG8_LDA(dst, b, h) do { _Pragma("unroll") for (int m = 0; m < 4; ++m) _Pragma("unroll") for (int k = 0; k < 2; ++k) dst[m][k] = *(const LAS bf16x8*)(lds + PG8_SA(b, h) + aoff + m * 2048 + k * 1024); } while (0)
#define PG8_LDB(dst, b, h) do { _Pragma("unroll") for (int n = 0; n < 2; ++n) _Pragma("unroll") for (int k = 0; k < 2; ++k) dst[n][k] = *(const LAS bf16x8*)(lds + PG8_SB(b, h) + boff + n * 2048 + k * 1024); } while (0)
#define PG8_MMA(ai, bj, At, Bt) do { __builtin_amdgcn_s_setprio(0); _Pragma("unroll") for (int m = 0; m < 4; ++m) _Pragma("unroll") for (int n = 0; n < 2; ++n) _Pragma("unroll") for (int k = 0; k < 2; ++k) \
        acc[ai][bj][m][n] = __builtin_amdgcn_mfma_f32_16x16x32_bf16(Bt[n][k], At[m][k], acc[ai][bj][m][n], 0, 0, 0); __builtin_amdgcn_s_setprio(0); } while (0)
#define PG8_WAIT_V(n) asm volatile("s_waitcnt vmcnt(" #n ")" ::: "memory")
#define PG8_WAIT_L(n) asm volatile("s_waitcnt lgkmcnt(" #n ")" ::: "memory")
#define PG8_BAR __builtin_amdgcn_s_barrier()
#define PG8_SCHED __builtin_amdgcn_sched_barrier(0)
    Unit cur, nxt; int ui = 0;
    if (!S.next(0, cur)) return;
    f32x4 acc[2][2][4][2];
#pragma unroll
    for (int a = 0; a < 2; ++a)
#pragma unroll
        for (int b = 0; b < 2; ++b)
#pragma unroll
            for (int m = 0; m < 4; ++m)
#pragma unroll
                for (int n = 0; n < 2; ++n) acc[a][b][m][n] = (f32x4){0.f, 0.f, 0.f, 0.f};
    bf16x8 At[4][2], B0[2][2], B1[2][2];
    const char* cA = (const char*)g.A + (size_t)cur.pm * tA; const char* cB = (const char*)g.Bt + (size_t)cur.pn * tB;
    PG8_STAGE(PG8_SB(0, 0), cB, voffB); PG8_STAGE(PG8_SB(0, 1), cB + hB, voffB); PG8_STAGE(PG8_SA(0, 0), cA, voffA); PG8_STAGE(PG8_SA(0, 1), cA + hA, voffA);
    if (wr == 1) PG8_BAR;
    PG8_WAIT_V(2); PG8_BAR;
    PG8_STAGE(PG8_SB(1, 0), cB + kstep, voffB); PG8_STAGE(PG8_SA(1, 0), cA + kstep, voffA); PG8_STAGE(PG8_SB(1, 1), cB + hB + kstep, voffB);
    PG8_WAIT_V(6); PG8_BAR;
    for (;;) {
        const bool has_next = S.next(ui + 1, nxt);
        const char* nA = has_next ? (const char*)g.A + (size_t)nxt.pm * tA : cA; const char* nB = has_next ? (const char*)g.Bt + (size_t)nxt.pn * tB : cB;
        for (int t = 0; t < nt; t += 2) {
            const bool last = (t == nt - 2);
            const char* a1 = cA + (size_t)(t + 1) * kstep;
            const char* a2 = last ? nA : cA + (size_t)(t + 2) * kstep; const char* b2 = last ? nB : cB + (size_t)(t + 2) * kstep;
            const char* a3 = a2 + kstep; const char* b3 = b2 + kstep;
            if constexpr (Hook::ON) HK(acc, cur, t, wr, wc, fr, fq);
            PG8_LDB(B0, 0, 0); PG8_LDB(B1, 0, 1); PG8_SCHED; PG8_LDA(At, 0, 0); PG8_STAGE(PG8_SA(1, 1), a1 + hA, voffA);
            PG8_WAIT_V(8); PG8_WAIT_L(0); PG8_BAR; PG8_MMA(0, 0, At, B0); PG8_MMA(0, 1, At, B1); PG8_BAR; PG8_SCHED;
            PG8_LDA(At, 0, 1); PG8_STAGE(PG8_SB(0, 0), b2, voffB); PG8_STAGE(PG8_SB(0, 1), b2 + hB, voffB); PG8_STAGE(PG8_SA(0, 0), a2, voffA);
            PG8_WAIT_V(8); PG8_WAIT_L(0); PG8_BAR; PG8_MMA(1, 0, At, B0); PG8_MMA(1, 1, At, B1); PG8_BAR; PG8_SCHED;
            PG8_LDB(B0, 1, 0); PG8_LDB(B1, 1, 1); PG8_SCHED; PG8_LDA(At, 1, 0); PG8_STAGE(PG8_SA(0, 1), a2 + hA, voffA);
            PG8_WAIT_V(8); PG8_WAIT_L(0); PG8_BAR; PG8_MMA(0, 0, At, B0); PG8_MMA(0, 1, At, B1); PG8_BAR; PG8_SCHED;
            PG8_LDA(At, 1, 1); PG8_STAGE(PG8_SB(1, 0), b3, voffB); PG8_STAGE(PG8_SB(1, 1), b3 + hB, voffB); PG8_STAGE(PG8_SA(1, 0), a3, voffA);
            PG8_WAIT_V(8); PG8_WAIT_L(0); PG8_BAR; PG8_MMA(1, 0, At, B0); PG8_MMA(1, 1, At, B1); PG8_BAR; PG8_SCHED;
        }
        if (wr == 0) PG8_BAR;
        E(acc, cur, wr, wc, fr, fq);
        if (!has_next) break;
#pragma unroll
        for (int a = 0; a < 2; ++a)
#pragma unroll
            for (int b = 0; b < 2; ++b)
#pragma unroll
                for (int m = 0; m < 4; ++m)
#pragma unroll
                    for (int n = 0; n < 2; ++n) acc[a][b][m][n] = (f32x4){0.f, 0.f, 0.f, 0.f};
        cur = nxt; cA = nA; cB = nB; ++ui;
        if (wr == 1) PG8_BAR;
    }
    PG8_WAIT_V(0);
    PG8_BAR;
#undef PG8_SA
#undef PG8_SB
#undef PG8_STAGE
#undef PG8_LDA
#undef PG8_LDB
#undef PG8_MMA
#undef PG8_WAIT_V
#undef PG8_WAIT_L
#undef PG8_BAR
#undef PG8_SCHED
}
}

namespace at {
constexpr int KSTR = 272, VSTR = 320;
constexpr int AT_K = 0, AT_V = 2 * 64 * KSTR, AT_TAB = AT_V + 2 * 64 * VSTR, AT_END = AT_TAB + 640 * 4;
__device__ __forceinline__ s16x4 vtr(const LAS unsigned char* p) { return __builtin_bit_cast(s16x4, __builtin_amdgcn_ds_read_tr16_b64_v4i16((LAS s16x4*)p)); }

template <bool CH, bool KN>
__device__ __forceinline__ void attn_unit(LAS unsigned char* lds, const bf16_t* QO, const bf16_t* SZ, int ldq, bf16_t* OB, int ldo, const bf16_t* Kb, const bf16_t* Vb, int ldk,
                                          int q_row0, int k_row0, int jstart, int ntiles, const float* gq, const float* gk, const float* rel) {
    int tid_ = threadIdx.x; asm volatile("" : "+v"(tid_));
    const int tid = tid_, lane = tid & 63, w = __builtin_amdgcn_readfirstlane(tid >> 6), r32 = lane & 31, hh = lane >> 5;
    LAS float* tab = (LAS float*)(lds + AT_TAB);
    if (CH) { for (int e = tid; e < 640; e += 512) { int idx = e - 63; idx = idx < -256 ? -256 : (idx > 256 ? 256 : idx); tab[e] = rel[(idx + 256) * 8] * LOG2E; } }
    const int srow = tid >> 4, sc = tid & 15;
    const f32x4 gk0 = *(const f32x4*)(gk + 8 * sc), gk1 = *(const f32x4*)(gk + 8 * sc + 4);
    u32x4 kr[2], vr[2];
#define AT_GLOAD(j) do { const size_t ro_ = (size_t)(k_row0 + (j) * 64 + srow) * ldk + 8 * sc; \
        kr[0] = *(const u32x4*)(Kb + ro_); kr[1] = *(const u32x4*)(Kb + ro_ + (size_t)32 * ldk); vr[0] = *(const u32x4*)(Vb + ro_); vr[1] = *(const u32x4*)(Vb + ro_ + (size_t)32 * ldk); } while (0)
#define AT_SSTORE(buf) do { _Pragma("unroll") for (int i_ = 0; i_ < 2; ++i_) { const u32x4 kq = kr[i_]; u32x4 kn = kq; \
        if (KN) { float s_ = bflo(kq.x) * bflo(kq.x) + bfhi(kq.x) * bfhi(kq.x) + bflo(kq.y) * bflo(kq.y) + bfhi(kq.y) * bfhi(kq.y) + bflo(kq.z) * bflo(kq.z) + bfhi(kq.z) * bfhi(kq.z) + bflo(kq.w) * bflo(kq.w) + bfhi(kq.w) * bfhi(kq.w); \
        s_ = row16_sum(s_); \
        const float rk_ = rsqrtf(s_ * (1.0f / 128.0f) + EPS); \
        kn.x = pk2(bflo(kq.x) * rk_ * gk0[0], bfhi(kq.x) * rk_ * gk0[1]); kn.y = pk2(bflo(kq.y) * rk_ * gk0[2], bfhi(kq.y) * rk_ * gk0[3]); \
        kn.z = pk2(bflo(kq.z) * rk_ * gk1[0], bfhi(kq.z) * rk_ * gk1[1]); kn.w = pk2(bflo(kq.w) * rk_ * gk1[2], bfhi(kq.w) * rk_ * gk1[3]); } \
        *(LAS u32x4*)(lds + AT_K + (buf) * (64 * KSTR) + (srow + 32 * i_) * KSTR + 16 * sc) = kn; \
        *(LAS u32x4*)(lds + AT_V + (buf) * (64 * VSTR) + (srow + 32 * i_) * VSTR + 16 * sc) = vr[i_]; } } while (0)

    AT_GLOAD(jstart);
    const int qrow = q_row0 + 32 * w + r32;
    bf16x8 qf[8];
    {
        const bf16_t* qp = QO + (size_t)qrow * ldq + 8 * hh;
        u32x4 qraw[8];
#pragma unroll
        for (int ds = 0; ds < 8; ++ds) qraw[ds] = *(const u32x4*)(qp + 16 * ds);
        float ss = 0.f;
#pragma unroll
        for (int ds = 0; ds < 8; ++ds)
#pragma unroll
            for (int k = 0; k < 4; ++k) { const float a = bflo(qraw[ds][k]), b = bfhi(qraw[ds][k]); ss += a * a + b * b; }
        ss = half_sum(ss);
        const float rs = rsqrtf(ss * (1.0f / 128.0f) + EPS) * (0.08838834764831845f * LOG2E);
#pragma unroll
        for (int ds = 0; ds < 8; ++ds) {
            const f32x4 g0 = *(const f32x4*)(gq + 16 * ds + 8 * hh), g1 = *(const f32x4*)(gq + 16 * ds + 8 * hh + 4);
            u32x4 o;
            o.x = pk2(bflo(qraw[ds].x) * rs * g0[0], bfhi(qraw[ds].x) * rs * g0[1]); o.y = pk2(bflo(qraw[ds].y) * rs * g0[2], bfhi(qraw[ds].y) * rs * g0[3]);
            o.z = pk2(bflo(qraw[ds].z) * rs * g1[0], bfhi(qraw[ds].z) * rs * g1[1]); o.w = pk2(bflo(qraw[ds].w) * rs * g1[2], bfhi(qraw[ds].w) * rs * g1[3]);
            qf[ds] = __builtin_bit_cast(bf16x8, o);
        }
    }
    float mrun = -1e30f, lsum = 0.f;
    f32x16 o[4];
#pragma unroll
    for (int db = 0; db < 4; ++db)
#pragma unroll
        for (int i = 0; i < 16; ++i) o[db][i] = 0.f;
    AT_SSTORE(0);
    if (jstart + 1 < ntiles) AT_GLOAD(jstart + 1);
    __syncthreads();
#pragma unroll 1
    for (int j = jstart; j < ntiles; ++j) {
        const int buf = (j - jstart) & 1;
        const int jj = j - (w >> 1);
        const bool active = !CH || (jj >= 0 && jj <= 8);
        bf16x8 pf[2][2];
        if (active) {
            const LAS unsigned char* Kt = lds + AT_K + buf * (64 * KSTR) + r32 * KSTR + 16 * hh;
            f32x16 p0, p1;
            {
                bf16x8 kf[16];
#pragma unroll
                for (int ds = 0; ds < 8; ++ds) { kf[2 * ds] = *(const LAS bf16x8*)(Kt + 32 * ds); kf[2 * ds + 1] = *(const LAS bf16x8*)(Kt + 32 * KSTR + 32 * ds); }
                __builtin_amdgcn_sched_barrier(0);
                if (CH && jj <= 3) {
                    const float init = tab[638];
#pragma unroll
                    for (int i = 0; i < 16; ++i) { p0[i] = init; p1[i] = init; }
                    p0 = __builtin_amdgcn_mfma_f32_32x32x16_bf16(kf[0], qf[0], p0, 0, 0, 0);
                    p1 = __builtin_amdgcn_mfma_f32_32x32x16_bf16(kf[1], qf[0], p1, 0, 0, 0);
                } else {
                    const f32x16 zero16 = {0.f, 0.f, 0.f, 0.f, 0.f, 0.f, 0.f, 0.f, 0.f, 0.f, 0.f, 0.f, 0.f, 0.f, 0.f, 0.f};
                    p0 = __builtin_amdgcn_mfma_f32_32x32x16_bf16(kf[0], qf[0], zero16, 0, 0, 0);
                    p1 = __builtin_amdgcn_mfma_f32_32x32x16_bf16(kf[1], qf[0], zero16, 0, 0, 0);
                }
#pragma unroll
                for (int ds = 1; ds < 8; ++ds) {
                    p0 = __builtin_amdgcn_mfma_f32_32x32x16_bf16(kf[2 * ds], qf[ds], p0, 0, 0, 0);
                    p1 = __builtin_amdgcn_mfma_f32_32x32x16_bf16(kf[2 * ds + 1], qf[ds], p1, 0, 0, 0);
                }
            }
            if (CH && jj >= 4) {
                const LAS float* tb = tab + ((8 - jj) * 64 + 32 * (w & 1) + r32 - 4 * hh);
#pragma unroll
                for (int i = 0; i < 16; ++i) { p0[i] += tb[63 - (i & 3) - 8 * (i >> 2)]; p1[i] += tb[31 - (i & 3) - 8 * (i >> 2)]; }
            }
            float rm = __builtin_fmaxf(__builtin_fmaxf(p0[0], p1[0]), p0[1]);
#pragma unroll
            for (int i = 1; i < 15; ++i) rm = __builtin_fmaxf(__builtin_fmaxf(rm, p1[i]), p0[i + 1]);
            rm = half_max(__builtin_fmaxf(rm, p1[15]));
            const bool need = rm > mrun + 8.0f;
            if (__any(need)) {
                const float mn = need ? rm : mrun;
                const float alpha = __builtin_amdgcn_exp2f(mrun - mn);
                mrun = mn; lsum *= alpha;
#pragma unroll
                for (int db = 0; db < 4; ++db)
#pragma unroll
                    for (int i = 0; i < 16; ++i) o[db][i] *= alpha;
            }
            float ps = 0.f;
#pragma unroll
            for (int i = 0; i < 16; ++i) { p0[i] = __builtin_amdgcn_exp2f(p0[i] - mrun); p1[i] = __builtin_amdgcn_exp2f(p1[i] - mrun); ps += p0[i] + p1[i]; }
            lsum += ps;
#pragma unroll
            for (int s = 0; s < 2; ++s) {
                u32x4 a, b;
                a.x = pk2(p0[8 * s + 0], p0[8 * s + 1]); a.y = pk2(p0[8 * s + 2], p0[8 * s + 3]); a.z = pk2(p0[8 * s + 4], p0[8 * s + 5]); a.w = pk2(p0[8 * s + 6], p0[8 * s + 7]);
                b.x = pk2(p1[8 * s + 0], p1[8 * s + 1]); b.y = pk2(p1[8 * s + 2], p1[8 * s + 3]); b.z = pk2(p1[8 * s + 4], p1[8 * s + 5]); b.w = pk2(p1[8 * s + 6], p1[8 * s + 7]);
                pf[0][s] = __builtin_bit_cast(bf16x8, a); pf[1][s] = __builtin_bit_cast(bf16x8, b);
            }
        }
        if (j + 1 < ntiles) { AT_SSTORE(buf ^ 1); if (j + 2 < ntiles) AT_GLOAD(j + 2); }
        if (active) {
            const LAS unsigned char* Vt = lds + AT_V + buf * (64 * VSTR) + (4 * hh + ((lane & 15) >> 2)) * VSTR + (16 * ((lane >> 4) & 1) + 4 * (lane & 3)) * 2;
            s16x4 va[2][4][2];
#define AT_VLOAD(slot, g) do { _Pragma("unroll") for (int db_ = 0; db_ < 4; ++db_) { va[slot][db_][0] = vtr(Vt + (((g) >> 1) * 32 + 16 * ((g) & 1)) * VSTR + 64 * db_); va[slot][db_][1] = vtr(Vt + (((g) >> 1) * 32 + 16 * ((g) & 1) + 8) * VSTR + 64 * db_); } } while (0)
            AT_VLOAD(0, 0);
#pragma unroll
            for (int g = 0; g < 4; ++g) {
                if (g < 3) AT_VLOAD((g + 1) & 1, g + 1);
                __builtin_amdgcn_sched_barrier(0);
#pragma unroll
                for (int db = 0; db < 4; ++db) {
                    const bf16x8 vf = __builtin_shufflevector(va[g & 1][db][0], va[g & 1][db][1], 0, 1, 2, 3, 4, 5, 6, 7);
                    o[db] = __builtin_amdgcn_mfma_f32_32x32x16_bf16(vf, pf[g >> 1][g & 1], o[db], 0, 0, 0);
                }
                __builtin_amdgcn_sched_barrier(0);
            }
#undef AT_VLOAD
        }
        __syncthreads();
    }
#undef AT_GLOAD
#undef AT_SSTORE
    const float l = half_sum(lsum);
    const float inv = 1.0f / l;
    bf16_t* op = OB + (size_t)qrow * ldo + 4 * hh; const bf16_t* zp = SZ + (size_t)qrow * ldq + 4 * hh;
#pragma unroll
    for (int db = 0; db < 4; ++db)
#pragma unroll
        for (int g = 0; g < 4; ++g) {
            const int d = 32 * db + 8 * g;
            const u32x2 z = *(const u32x2*)(zp + d);
            u32x2 r;
            r.x = pk2(o[db][4 * g + 0] * inv * bflo(z.x), o[db][4 * g + 1] * inv * bfhi(z.x));
            r.y = pk2(o[db][4 * g + 2] * inv * bflo(z.y), o[db][4 * g + 3] * inv * bfhi(z.y));
            *(u32x2*)(op + d) = r;
        }
}
}


#define XB_TMO      128
#define XB_XCNT(j)  (256  + 64 * (j))
#define XB_XSUB(j)  (1280 + 64 * (j))
#define XB_XGEN(j)  (2304 + 64 * (j))
#define XB_TOP      3328
#define XB_TOPGEN   3392
#define XCD_BAR_WORDS 3456
#define XB_SPIN_CAP (1u << 18)
__device__ __forceinline__ unsigned xb_ld(unsigned* p)              { return __hip_atomic_load(p, __ATOMIC_RELAXED, __HIP_MEMORY_SCOPE_AGENT); }
__device__ __forceinline__ unsigned xb_add(unsigned* p, unsigned v) { return __hip_atomic_fetch_add(p, v, __ATOMIC_RELAXED, __HIP_MEMORY_SCOPE_AGENT); }
__device__ __forceinline__ unsigned xb_xcc_id() { return (unsigned)__builtin_amdgcn_s_getreg((3 << 11) | 20) & 0xFu; }
#define XB_SPIN(cond, bar) do { unsigned _sp = 0; while (cond) { __builtin_amdgcn_s_sleep(1); \
    if ((++_sp & 255u) == 0u) { if (xb_ld(&(bar)[XB_TMO])) break; if (_sp > XB_SPIN_CAP) { atomicAdd(&(bar)[XB_TMO], 1u); break; } } } } while (0)
struct XcdBarrier { unsigned* bar; unsigned x; volatile LAS unsigned* st; };
__device__ __forceinline__ XcdBarrier xcd_barrier_post(unsigned* bar, volatile LAS unsigned* st) {
    XcdBarrier b; b.bar = bar; b.x = xb_xcc_id(); b.st = st;
    if (threadIdx.x == 0) (void)xb_add(&bar[XB_XCNT(b.x)], 1u);
    return b;
}
__device__ __forceinline__ void xcd_barrier_complete(unsigned* bar, unsigned x, unsigned& nloc, unsigned& nx) {
    const unsigned G = gridDim.x * gridDim.y * gridDim.z;
    unsigned sum, cnt, mine, sp = 0u;
    for (;;) {
        sum = 0u; cnt = 0u; mine = 0u;
#pragma unroll
        for (unsigned j = 0; j < 16; ++j) { const unsigned c = xb_ld(&bar[XB_XCNT(j)]); sum += c; cnt += (c > 0u) ? 1u : 0u; mine = (j == x) ? c : mine; }
        if (sum == G) break;
        __builtin_amdgcn_s_sleep(1);
        if ((++sp & 255u) == 0u) { if (xb_ld(&bar[XB_TMO])) break; if (sp > XB_SPIN_CAP) { atomicAdd(&bar[XB_TMO], 1u); break; } }
    }
    nloc = mine > 0u ? mine : 1u; nx = cnt > 0u ? cnt : 1u;
}
__device__ __forceinline__ void xcd_barrier(const XcdBarrier& b) {
    asm volatile("s_waitcnt vmcnt(0)" ::: "memory");
    __syncthreads();
    if (threadIdx.x == 0) {
        unsigned* bar = b.bar;
        __builtin_amdgcn_s_waitcnt(0);
        unsigned nloc = b.st[0], nx = b.st[1];
        if (nloc == 0u) { xcd_barrier_complete(bar, b.x, nloc, nx); b.st[0] = nloc; b.st[1] = nx; }
        const unsigned old = xb_add(&bar[XB_XSUB(b.x)], 1u);
        const unsigned gen = old / nloc;
        if (old + 1u == (gen + 1u) * nloc) {
            __builtin_amdgcn_fence(__ATOMIC_RELEASE, "agent");
            asm volatile("s_waitcnt vmcnt(0)" ::: "memory");
            const unsigned og = xb_add(&bar[XB_TOP], 1u);
            const unsigned tg = og / nx;
            if (og + 1u == (tg + 1u) * nx) xb_add(&bar[XB_TOPGEN], 1u);
            else XB_SPIN(xb_ld(&bar[XB_TOPGEN]) == tg, bar);
            __builtin_amdgcn_fence(__ATOMIC_ACQUIRE, "agent");
            xb_add(&bar[XB_XGEN(b.x)], 1u);
            asm volatile("s_waitcnt vmcnt(0)" ::: "memory");
        } else {
            XB_SPIN(xb_ld(&bar[XB_XGEN(b.x)]) == gen, bar);
            __builtin_amdgcn_fence(__ATOMIC_ACQUIRE, "agent");
            asm volatile("s_waitcnt vmcnt(0)" ::: "memory");
        }
    }
    __syncthreads();
}

#ifndef WGM_P1
#define WGM_P1 4
#endif
#ifndef WGM_P4
#define WGM_P4 4
#endif
#ifndef WGM_C
#define WGM_C 4
#endif
constexpr int NWAVES = 8, NTHREADS = 512;
constexpr int LDS_BYTES = 147456;
constexpr size_t MiB = 1u << 20;
constexpr size_t SZ_WIN = (size_t)N_IN * D_MODEL * 2, SZ_WA = (size_t)D_MODEL * W_A * 2, SZ_WB = (size_t)D_MODEL * W_B * 2, SZ_WM = (size_t)D_MODEL * W_M * 2,
                 SZ_WO = (size_t)D_MODEL * D_MODEL * 2, SZ_WMEM = (size_t)(2 * W_M) * D_MODEL * 2;
constexpr size_t SZ_WL = SZ_WIN + SZ_WA + SZ_WB + SZ_WM + SZ_WO + SZ_WMEM;
constexpr size_t WS_SS = 131072;
constexpr size_t WS_CTL = 0, CTL_ZERO_BYTES = 16384;
constexpr size_t WS_W = 1 * MiB;
constexpr int LDS_MISC = 131072, LDS_XL = 131072 + 256;
constexpr size_t WS_MEMN = WS_W + DEPTH * SZ_WL;
constexpr size_t WS_MKV = WS_MEMN + (size_t)DEPTH * MMEM * D_MODEL * 2;
constexpr size_t WS_H = WS_MKV + (size_t)DEPTH * MMEM * (2 * W_M) * 2;
constexpr size_t WS_MERGED = WS_H + (size_t)MTOK * D_MODEL * 2;
constexpr size_t WS_PROJ = WS_MERGED + (size_t)MHALF * D_MODEL * 2;
constexpr size_t WS_GT = WS_PROJ + (size_t)MHALF * PJW * 2;
constexpr size_t WS_Y = WS_GT + (size_t)3 * 64 * 8 * 65536;
constexpr size_t WS_END = WS_Y + (size_t)MHALF * D_MODEL * 2;
constexpr int Y_A = 0, Y_B = 512, Y_M = 1536;
static_assert(WS_END <= (size_t)1024 * MiB, "workspace map must fit 1 GiB");

__device__ __forceinline__ void p0_transpose_item(const float* W, int K, int N, bf16_t* WT, int ldwt, LAS float* scr, int item, int lane) {
    const int nblk = N / 32, kb = item / nblk, nb = item % nblk, k0 = 64 * kb, n0 = 32 * nb;
#pragma unroll 8
    for (int i = 0; i < 32; ++i) { const int kk = 2 * i + (lane >> 5); scr[kk * 33 + (lane & 31)] = __builtin_nontemporal_load(&W[(size_t)(k0 + kk) * N + n0 + (lane & 31)]); }
    asm volatile("s_waitcnt lgkmcnt(0)" ::: "memory");
    const int c = lane & 7;
#pragma unroll
    for (int j = 0; j < 4; ++j) { const int n = (lane >> 3) + 8 * j; const LAS float* s = scr + (8 * c) * 33 + n;
        u32x4 o; o.x = pk2(s[0 * 33], s[1 * 33]); o.y = pk2(s[2 * 33], s[3 * 33]); o.z = pk2(s[4 * 33], s[5 * 33]); o.w = pk2(s[6 * 33], s[7 * 33]);
        *(u32x4*)(WT + (size_t)(n0 + n) * ldwt + k0 + 8 * c) = o; }
    asm volatile("s_waitcnt lgkmcnt(0)" ::: "memory");
}
__device__ __forceinline__ void rms_row_to_bf16(const float* xrow, const float* g, bf16_t* orow, int lane) {
    const f32x4* xr = (const f32x4*)xrow + lane; const f32x4* gr = (const f32x4*)g + lane;
    f32x4 v[8]; float s = 0.f;
#pragma unroll
    for (int j = 0; j < 8; ++j) { v[j] = xr[64 * j]; s += (v[j].x * v[j].x + v[j].y * v[j].y) + (v[j].z * v[j].z + v[j].w * v[j].w); }
    const float rstd = rsqrtf(wave_sum(s) * (1.f / D_MODEL) + EPS);
    u32x2* o8 = (u32x2*)orow + lane;
#pragma unroll
    for (int j = 0; j < 8; ++j) { const f32x4 gg = gr[64 * j]; u32x2 r; r.x = pk2(v[j].x * rstd * gg.x, v[j].y * rstd * gg.y); r.y = pk2(v[j].z * rstd * gg.z, v[j].w * rstd * gg.w); o8[64 * j] = r; }
}

__device__ __forceinline__ void scale_row_to_bf16(const float* xrow, const float* g, bf16_t* orow, float* ss_out, int lane) {
    const f32x4* xr = (const f32x4*)xrow + lane; const f32x4* gr = (const f32x4*)g + lane;
    f32x4 v[8]; float s = 0.f;
#pragma unroll
    for (int j = 0; j < 8; ++j) { v[j] = __builtin_nontemporal_load(&xr[64 * j]); s += (v[j].x * v[j].x + v[j].y * v[j].y) + (v[j].z * v[j].z + v[j].w * v[j].w); }
    s = wave_sum(s);
    if (lane == 0) *ss_out = s;
    u32x2* o8 = (u32x2*)orow + lane;
#pragma unroll
    for (int j = 0; j < 8; ++j) { const f32x4 gg = gr[64 * j]; u32x2 r; r.x = pk2(v[j].x * gg.x, v[j].y * gg.y); r.y = pk2(v[j].z * gg.z, v[j].w * gg.w); o8[64 * j] = r; }
}
struct Args { const float* in[17]; float* out; unsigned char* ws; };


#ifdef PROBE_SEL
#define TS_BEGIN(cat) do { if (PROBE_SEL == (cat)) tstart = __builtin_amdgcn_s_memrealtime(); } while (0)
#define TS_END(cat) do { if (PROBE_SEL == (cat)) tacc += __builtin_amdgcn_s_memrealtime() - tstart; } while (0)
#else
#define TS_BEGIN(cat) do {} while (0)
#define TS_END(cat) do {} while (0)
#endif
#ifndef PROBE_DUP
#define PROBE_DUP 0
#endif
constexpr int REP_P1 = (PROBE_DUP == 1) ? 2 : 1, REP_B = (PROBE_DUP == 2) ? 2 : 1, REP_C = (PROBE_DUP == 3) ? 2 : 1, REP_SYNC = (PROBE_DUP == 4) ? 2 : 1, REP_P0 = (PROBE_DUP == 5) ? 2 : 1, REP_P4 = (PROBE_DUP == 6) ? 2 : 1, REP_CA = (PROBE_DUP == 7) ? 2 : 1, REP_MA = (PROBE_DUP == 8) ? 2 : 1, REP_CV = (PROBE_DUP == 9) ? 2 : 1, REP_MA0 = (PROBE_DUP == 10) ? 2 : 1, REP_CA0 = (PROBE_DUP == 11) ? 2 : 1;
#define GSYNC() do { TS_BEGIN(5); for (int rs_ = 0; rs_ < REP_SYNC; ++rs_) xcd_barrier(xbar); TS_END(5); } while (0)
__global__ void __launch_bounds__(NTHREADS, 2) fwd_megakernel(Args args) {
#ifdef PROBE_SEL
    unsigned long long tstart = 0, tacc = 0;
#endif
    extern __shared__ __attribute__((aligned(16))) unsigned char lds_raw[];
    LAS unsigned char* lds = (LAS unsigned char*)lds_raw;
    cg::grid_group grid = cg::this_grid();
    const int tid = threadIdx.x, lane = tid & 63, wave = __builtin_amdgcn_readfirstlane(tid >> 6);
    const int G = gridDim.x, bx = blockIdx.x;
    const int gw = bx * NWAVES + wave, NGW = G * NWAVES;
    const int vcu = (G % 8 == 0) ? (bx % 8) * (G / 8) + bx / 8 : bx;
    unsigned char* ws = args.ws;
    if (tid < 2) ((volatile LAS unsigned*)(lds + LDS_MISC))[tid] = 0u;
    __syncthreads();
    const XcdBarrier xbar = xcd_barrier_post((unsigned*)(ws + WS_CTL), (volatile LAS unsigned*)(lds + LDS_MISC));
    float* out = args.out;
    bf16_t* Hb = (bf16_t*)(ws + WS_H); bf16_t* MERGED = (bf16_t*)(ws + WS_MERGED); bf16_t* PROJ = (bf16_t*)(ws + WS_PROJ); bf16_t* YB = (bf16_t*)(ws + WS_Y); bf16_t* GT = (bf16_t*)(ws + WS_GT); float* SSQ = (float*)(ws + WS_SS);
    bf16_t* MEMN = (bf16_t*)(ws + WS_MEMN); bf16_t* MKV = (bf16_t*)(ws + WS_MKV);
#define WT_IN(l)  ((bf16_t*)(ws + WS_W + (size_t)(l) * SZ_WL))
#define WT_A(l)   ((bf16_t*)(ws + WS_W + (size_t)(l) * SZ_WL + SZ_WIN))
#define WT_B(l)   ((bf16_t*)(ws + WS_W + (size_t)(l) * SZ_WL + SZ_WIN + SZ_WA))
#define WT_M(l)   ((bf16_t*)(ws + WS_W + (size_t)(l) * SZ_WL + SZ_WIN + SZ_WA + SZ_WB))
#define WT_O(l)   ((bf16_t*)(ws + WS_W + (size_t)(l) * SZ_WL + SZ_WIN + SZ_WA + SZ_WB + SZ_WM))
#define WT_MEM(l) ((bf16_t*)(ws + WS_W + (size_t)(l) * SZ_WL + SZ_WIN + SZ_WA + SZ_WB + SZ_WM + SZ_WO))

#define PJB(col) (PROJ + (size_t)((col) >> 7) * MHALF * 128)
    TS_BEGIN(0);
    for (int rep = 0; rep < REP_P0; ++rep) {
        LAS float* scr = (LAS float*)(lds + wave * 16384);
        constexpr int I_IN = (D_MODEL / 64) * (N_IN / 32), I_A = (W_A / 64) * (D_MODEL / 32), I_B = (W_B / 64) * (D_MODEL / 32), I_M = (W_M / 64) * (D_MODEL / 32),
                      I_O = (D_MODEL / 64) * (D_MODEL / 32), I_MEM = (D_MODEL / 64) * (2 * W_M / 32);
        constexpr int I_L = I_IN + I_A + I_B + I_M + I_O + I_MEM;
        for (int it = gw; it < DEPTH * I_L; it += NGW) {
            const int l = it / I_L; int r = it % I_L;
            if (r < I_IN) { p0_transpose_item(args.in[3] + (size_t)l * D_MODEL * N_IN, D_MODEL, N_IN, WT_IN(l), D_MODEL, scr, r, lane); continue; } r -= I_IN;
            if (r < I_A) { p0_transpose_item(args.in[13] + (size_t)l * W_A * D_MODEL, W_A, D_MODEL, WT_A(l) + Y_A, D_MODEL, scr, r, lane); continue; } r -= I_A;
            if (r < I_B) { p0_transpose_item(args.in[14] + (size_t)l * W_B * D_MODEL, W_B, D_MODEL, WT_A(l) + Y_B, D_MODEL, scr, r, lane); continue; } r -= I_B;
            if (r < I_M) { p0_transpose_item(args.in[15] + (size_t)l * W_M * D_MODEL, W_M, D_MODEL, WT_A(l) + Y_M, D_MODEL, scr, r, lane); continue; } r -= I_M;
            if (r < I_O) { p0_transpose_item(args.in[16] + (size_t)l * D_MODEL * D_MODEL, D_MODEL, D_MODEL, WT_O(l), D_MODEL, scr, r, lane); continue; } r -= I_O;
            p0_transpose_item(args.in[10] + (size_t)l * D_MODEL * (2 * W_M), D_MODEL, 2 * W_M, WT_MEM(l), D_MODEL, scr, r, lane);
        }
        for (int m = gw; m < DEPTH * MMEM; m += NGW) { const int l = m / MMEM, r = m % MMEM;
            rms_row_to_bf16(args.in[1] + (size_t)r * D_MODEL, args.in[9] + (size_t)l * D_MODEL, MEMN + (size_t)m * D_MODEL, lane); }
        for (int m = gw; m < MTOK; m += NGW) { scale_row_to_bf16(args.in[0] + (size_t)m * D_MODEL, args.in[2], Hb + (size_t)m * D_MODEL, SSQ + m, lane); if (lane == 0) SSQ[MTOK + m] = 0.f; }
    }
    TS_END(0);
    if (args.ws == nullptr) grid.sync();
    GSYNC();

    for (int it = 0; it <= 4; ++it) {
        const int l = (it >> 1) & 1, half = it & 1;
        TS_BEGIN(1);
        if (it == 0) {
            for (int ll = 0; ll < DEPTH; ++ll) {
                pg8::Gemm g{MEMN + (size_t)ll * MMEM * D_MODEL, WT_MEM(ll), MMEM, 2 * W_M, D_MODEL, D_MODEL, D_MODEL};
                pg8::StaticOrder S; S.init(MMEM, 2 * W_M, G, (bx + 32 * ll) % G);
                pg8::EpiBf16 E{MKV + (size_t)ll * MMEM * (2 * W_M), 2 * W_M};
                pg8::gemm_phase<pg8::EpiBf16>(lds, g, S, E);
            }
        }
        if (it >= 1) {
            const int pl = ((it - 1) >> 1) & 1, ph = (it - 1) & 1;
            pg8::Gemm g{MERGED, WT_O(pl), MHALF, D_MODEL, D_MODEL, D_MODEL, D_MODEL};
            pg8::StaticOrder S; S.init(MHALF, D_MODEL, G, bx, WGM_P4);
            pg8::EpiResid E{args.in[0] + (size_t)ph * MHALF * D_MODEL, out + (size_t)ph * MHALF * D_MODEL, Hb + (size_t)ph * MHALF * D_MODEL, args.in[2] + D_MODEL, SSQ + MTOK + (size_t)ph * MHALF, pl == 0 ? 1 : 0};
            for (int rep = 0; rep < (pl == 0 ? REP_P4 : 1); ++rep) pg8::gemm_phase<pg8::EpiResid>(lds, g, S, E);
        }
        TS_END(1);
        if (it == 4) break;
        TS_BEGIN(2);
        for (int rep = 0; rep < REP_P1; ++rep) {
            pg8::Gemm g{Hb + (size_t)half * MHALF * D_MODEL, WT_IN(l), MHALF, N_IN, D_MODEL, D_MODEL, D_MODEL};
            pg8::StaticOrder S; S.init(MHALF, N_IN, G, bx, WGM_P1);
            pg8::EpiProj E{PROJ, PJW, args.in[4] + (size_t)l * 3 * D_MODEL, GT, SSQ + (size_t)l * MTOK + (size_t)half * MHALF, args.in[7] + (size_t)l * HEAD_DIM, (LAS float*)(lds + LDS_XL)};
            pg8::gemm_phase<pg8::EpiProj>(lds, g, S, E);
        }
        TS_END(2);
        GSYNC();
        TS_BEGIN(3);
        for (int rep = 0; rep < REP_B; ++rep) {
            for (int rp = 0; rp < REP_CA * REP_CA0; ++rp)
            for (int u = vcu; u < 4 * H_B * 16; u += G) {
                const int qb = u & 15, hd = (u >> 4) & 7, bb = u >> 7;
                const int n0 = 4 * qb, jstart = (8 - n0) > 0 ? (8 - n0) : 0;
                at::attn_unit<true, false>(lds, PJB(C_Q + hd * HEAD_DIM), PJB(C_BZ + hd * HEAD_DIM), HEAD_DIM, YB + Y_B + hd * HEAD_DIM, D_MODEL, PJB(C_K + hd * HEAD_DIM), PJB(C_V + hd * HEAD_DIM), HEAD_DIM,
                                    bb * SEQ + qb * 256, bb * SEQ + (n0 - 8) * CHUNK, jstart, (REP_CA0 == 2 && rp == 0) ? jstart : 12,
                                    args.in[6] + (size_t)l * HEAD_DIM, args.in[7] + (size_t)l * HEAD_DIM, args.in[8] + (size_t)l * 513 * H_B + hd);
            }
            for (int rp = 0; rp < REP_MA * REP_MA0; ++rp)
            for (int u = vcu; u < 4 * H_M * 16; u += G) {
                const int qb = u & 15, hd = (u >> 4) & 3, bb = u >> 6;
                const bf16_t* kv = MKV + (size_t)l * MMEM * (2 * W_M) + hd * HEAD_DIM;
                at::attn_unit<false, true>(lds, PJB(C_MQ + hd * HEAD_DIM), PJB(C_MZ + hd * HEAD_DIM), HEAD_DIM, YB + Y_M + hd * HEAD_DIM, D_MODEL, kv, kv + W_M, 2 * W_M,
                                     bb * SEQ + qb * 256, (half * 4 + bb) * MEM_LEN, 0, (REP_MA0 == 2 && rp == 0) ? 0 : 4,
                                     args.in[11] + (size_t)l * HEAD_DIM, args.in[12] + (size_t)l * HEAD_DIM, args.in[8]);
            }
            {
                int lane_ = threadIdx.x & 63; asm volatile("" : "+v"(lane_)); const int lane = lane_;
                const float* cw = args.in[5] + (size_t)l * 3 * W_A + 8 * lane;
                f32x4 wv[3][2];
#pragma unroll
                for (int tp = 0; tp < 3; ++tp) { wv[tp][0] = *(const f32x4*)(cw + tp * W_A); wv[tp][1] = *(const f32x4*)(cw + tp * W_A + 4); }
                for (int rp = 0; rp < REP_CV; ++rp)
                for (int r = gw; r < MHALF; r += NGW) {
                    const int t = r & (SEQ - 1);
                    const bf16_t* base = PROJ + ((size_t)(lane >> 4) * MHALF + r) * 128 + 8 * (lane & 15);
                    const u32x4 ab = *(const u32x4*)(base + (size_t)C_AB * MHALF), az = *(const u32x4*)(base + (size_t)C_AZ * MHALF);
                    float acc[8];
#pragma unroll
                    for (int k = 0; k < 8; ++k) acc[k] = 0.f;
#pragma unroll
                    for (int tp = 0; tp < 3; ++tp) {
                        const int dt = 2 - tp;
                        if (t >= dt) {
                            const bf16_t* pb = base - (size_t)dt * 128;
                            const u32x4 ac = *(const u32x4*)(pb + (size_t)C_AC * MHALF), ax = *(const u32x4*)(pb + (size_t)C_AX * MHALF);
#pragma unroll
                            for (int k = 0; k < 4; ++k) { acc[2 * k] += wv[tp][k >> 1][(2 * k) & 3] * bflo(ac[k]) * bflo(ax[k]); acc[2 * k + 1] += wv[tp][k >> 1][(2 * k + 1) & 3] * bfhi(ac[k]) * bfhi(ax[k]); }
                        }
                    }
                    u32x4 o;
#pragma unroll
                    for (int k = 0; k < 4; ++k) o[k] = pk2(bflo(ab[k]) * acc[2 * k] * bflo(az[k]), bfhi(ab[k]) * acc[2 * k + 1] * bfhi(az[k]));
                    *(u32x4*)(YB + (size_t)r * D_MODEL + Y_A + 8 * lane) = o;
                }
            }
        }
        TS_END(3);
        GSYNC();
        TS_BEGIN(4);
        for (int rep = 0; rep < REP_C; ++rep) {
            pg8::StaticOrder S; S.init(MHALF, D_MODEL, G, bx, WGM_C);
            pg8::Gemm g{YB, WT_A(l), MHALF, D_MODEL, D_MODEL, D_MODEL, D_MODEL};
            pg8::EpiGateFinal E{GT, MERGED};
            pg8::HookGate HK{GT};
            pg8::gemm_phase<pg8::EpiGateFinal, pg8::HookGate>(lds, g, S, E, HK);
        }
        TS_END(4);
        GSYNC();
    }
#ifdef PROBE_SEL
    grid.sync();
    if (bx == 0 && tid == 0) out[0] = (float)tacc * 0.01f;
#endif
}

extern "C" void kernel_launch(void* const* d_in, const int* in_sizes, int n_in, void* d_out, int out_size, void* d_ws, size_t ws_size, hipStream_t stream) {
    static int grid_blocks = 0;
    if (grid_blocks == 0) {
        if (n_in != 17 || in_sizes[0] != MTOK * D_MODEL || out_size != MTOK * D_MODEL || ws_size < WS_END) {
            fprintf(stderr, "kernel_launch: unexpected shapes (n_in %d, in0 %d, out %d, ws %zu < %zu); nothing launched\n", n_in, n_in > 0 ? in_sizes[0] : -1, out_size, ws_size, (size_t)WS_END);
            grid_blocks = -1; return; }
        int dev = 0, cus = 0, per_cu = 0;
        hipGetDevice(&dev);
        hipDeviceGetAttribute(&cus, hipDeviceAttributeMultiprocessorCount, dev);
        hipFuncSetAttribute((const void*)fwd_megakernel, hipFuncAttributeMaxDynamicSharedMemorySize, LDS_BYTES);
        hipOccupancyMaxActiveBlocksPerMultiprocessor(&per_cu, (const void*)fwd_megakernel, NTHREADS, LDS_BYTES);
        if (per_cu < 1) per_cu = 1;
        grid_blocks = cus * per_cu;
        (void)hipGetLastError();
    }
    if (grid_blocks < 0) return;
    if (hipMemsetAsync((char*)d_ws + WS_CTL, 0, CTL_ZERO_BYTES, stream) != hipSuccess) { fprintf(stderr, "kernel_launch: memset of barrier words failed\n"); return; }
    Args a{};
    for (int i = 0; i < 17; ++i) a.in[i] = (const float*)d_in[i];
    a.out = (float*)d_out; a.ws = (unsigned char*)d_ws;
    void* kargs[] = {&a};
    hipError_t e = hipLaunchCooperativeKernel((const void*)fwd_megakernel, dim3(grid_blocks), dim3(NTHREADS), kargs, LDS_BYTES, stream);
    if (e != hipSuccess) fprintf(stderr, "cooperative launch failed: %s (grid %d)\n", hipGetErrorString(e), grid_blocks);
}
```
